# Optimizing an MI355X kernel written in HIP

```python
import jax, jax.numpy as jnp
from jax import lax
import numpy as np

D_MODEL = 1024
BATCH = 8
SEQ = 2048
DEPTH = 2

HEAD_DIM = 64
ATTN_HEADS = 8
ATTN_KV_HEADS = 2
ATTN_GROUP = ATTN_HEADS // ATTN_KV_HEADS
WINDOW = 128
ATTN_BLOCK = 128
ROPE_THETA = 10000.0

RET_HEADS = 4
RET_DK = 64
RET_DV = 64
RET_CHUNK = 128

GLA_HEADS = 4
GLA_DK = 32
GLA_DV = 64
GLA_CHUNK = 64
GLA_GATE_RANK = 16
GLA_GATE_NORMALIZER = 16.0

EPS = 1e-6

ATTN_W = ATTN_HEADS * HEAD_DIM
RET_W = RET_HEADS * RET_DV
GLA_W = GLA_HEADS * GLA_DV
D_MIX = ATTN_W + RET_W + GLA_W

IN_SIZES = (
    ATTN_HEADS * HEAD_DIM, ATTN_KV_HEADS * HEAD_DIM, ATTN_KV_HEADS * HEAD_DIM, ATTN_W,
    RET_HEADS * RET_DK, RET_HEADS * RET_DK, RET_HEADS * RET_DV, RET_W,
    GLA_HEADS * GLA_DK, GLA_HEADS * GLA_DK, GLA_HEADS * GLA_DV, GLA_W,
    GLA_GATE_RANK,
)
D_IN = sum(IN_SIZES)
IN_SPLITS = [int(s) for s in np.cumsum(IN_SIZES)[:-1]]

kernel_name = "hymba_style_swa_retention_gla_hybrid"


def rms_norm(x, gain=None):
    xf = x.astype(jnp.float32)
    y = xf * lax.rsqrt(jnp.mean(xf * xf, axis=-1, keepdims=True) + EPS)
    if gain is not None:
        y = y * gain.astype(jnp.float32)
    return y.astype(x.dtype)


def apply_rotary(x, positions, inv_freq):
    ang = positions.astype(jnp.float32)[..., None] * inv_freq
    cos = jnp.cos(ang)[:, :, None, :]
    sin = jnp.sin(ang)[:, :, None, :]
    x1, x2 = jnp.split(x.astype(jnp.float32), 2, axis=-1)
    out = jnp.concatenate([x1 * cos - x2 * sin, x2 * cos + x1 * sin], axis=-1)
    return out.astype(x.dtype)


def sliding_window_attention(q, k, v, sinks):
    B, S, H, D = q.shape
    nb = S // ATTN_BLOCK
    qb = q.reshape(B, nb, ATTN_BLOCK, ATTN_KV_HEADS, ATTN_GROUP, D)
    kb = k.reshape(B, nb, ATTN_BLOCK, ATTN_KV_HEADS, D)
    vb = v.reshape(B, nb, ATTN_BLOCK, ATTN_KV_HEADS, D)

    def with_prev(t):
        prev = jnp.pad(t, ((0, 0), (1, 0), (0, 0), (0, 0), (0, 0)))[:, :-1]
        return jnp.concatenate([prev, t], axis=2)

    kk, vv = with_prev(kb), with_prev(vb)
    s = jnp.einsum('bnqhgd,bnkhd->bnhgqk', qb, kk).astype(jnp.float32) * (D ** -0.5)
    i = jnp.arange(ATTN_BLOCK)[:, None]
    j = jnp.arange(2 * ATTN_BLOCK)[None, :]
    rel = i + ATTN_BLOCK - j
    kpos = (jnp.arange(nb)[:, None] - 1) * ATTN_BLOCK + jnp.arange(2 * ATTN_BLOCK)[None, :]
    valid = ((rel >= 0) & (rel < WINDOW))[None] & (kpos >= 0)[:, None, :]
    s = jnp.where(valid[None, :, None, None], s, -1e30)
    sink = sinks.astype(jnp.float32).reshape(ATTN_KV_HEADS, ATTN_GROUP)[None, None, :, :, None, None]
    sink = jnp.broadcast_to(sink, s.shape[:-1] + (1,))
    p = jax.nn.softmax(jnp.concatenate([s, sink], axis=-1), axis=-1)[..., :-1]
    o = jnp.einsum('bnhgqk,bnkhd->bnqhgd', p.astype(v.dtype), vv)
    return o.reshape(B, S, H * D)


def retention(q, k, v):
    B, S, H, Dk = q.shape
    Dv = v.shape[-1]
    C = RET_CHUNK
    nc = S // C
    f32 = jnp.float32
    log_g = jnp.log(1.0 - 2.0 ** (-5.0 - jnp.arange(H, dtype=f32)))
    idx = jnp.arange(C, dtype=f32)
    diff = idx[:, None] - idx[None, :]
    dmask = jnp.where(diff >= 0, jnp.exp(log_g[:, None, None] * jnp.maximum(diff, 0.0)), 0.0)
    q_decay = jnp.exp(log_g[:, None] * (idx + 1.0))[..., None]
    k_decay = jnp.exp(log_g[:, None] * (C - 1.0 - idx))[..., None]
    chunk_decay = jnp.exp(log_g * C)[:, None, None]

    def to_chunks(t):
        return t.astype(f32).reshape(B, nc, C, H, t.shape[-1]).transpose(1, 0, 3, 2, 4)

    qc, kc, vc = to_chunks(q), to_chunks(k * (Dk ** -0.5)), to_chunks(v)

    def step(state, inp):
        qi, ki, vi = inp
        sc = jnp.einsum('bhid,bhjd->bhij', qi, ki) * dmask
        intra = jnp.einsum('bhij,bhjv->bhiv', sc, vi)
        inter = jnp.einsum('bhid,bhdv->bhiv', qi * q_decay, state)
        new_state = chunk_decay * state + jnp.einsum('bhjd,bhjv->bhdv', ki * k_decay, vi)
        return new_state, intra + inter

    state0 = jnp.zeros((B, H, Dk, Dv), f32)
    _, out = lax.scan(step, state0, (qc, kc, vc))
    return out.transpose(1, 0, 3, 2, 4).reshape(B, S, H, Dv).astype(v.dtype)


def gated_linear_attention(q, k, v, log_a):
    B, S, H, Dk = q.shape
    Dv = v.shape[-1]
    C = GLA_CHUNK
    nc = S // C
    f32 = jnp.float32

    def to_chunks(t):
        return t.astype(f32).reshape(B, nc, C, H, t.shape[-1]).transpose(1, 0, 3, 2, 4)

    qc, kc, vc, gc = to_chunks(q * (Dk ** -0.5)), to_chunks(k), to_chunks(v), to_chunks(log_a)
    causal = jnp.tril(jnp.ones((C, C), dtype=bool))[..., None]

    def step(state, inp):
        qi, ki, vi, gi = inp
        b = jnp.cumsum(gi, axis=2)
        rel = b[:, :, :, None, :] - b[:, :, None, :, :]
        decay = jnp.where(causal, jnp.exp(jnp.minimum(rel, 0.0)), 0.0)
        sc = jnp.einsum('bhid,bhijd,bhjd->bhij', qi, decay, ki)
        intra = jnp.einsum('bhij,bhjv->bhiv', sc, vi)
        inter = jnp.einsum('bhid,bhdv->bhiv', qi * jnp.exp(b), state)
        b_last = b[:, :, -1:, :]
        new_state = (jnp.exp(b_last)[:, :, 0, :, None] * state
                     + jnp.einsum('bhjd,bhjv->bhdv', ki * jnp.exp(b_last - b), vi))
        return new_state, intra + inter

    state0 = jnp.zeros((B, H, Dk, Dv), f32)
    _, out = lax.scan(step, state0, (qc, kc, vc, gc))
    return out.transpose(1, 0, 3, 2, 4).reshape(B, S, H, Dv).astype(v.dtype)


def hybrid_layer(x, c_act, positions, w_mod, b_mod, pre_gain, post_gain, w_in, sinks,
                 gla_gate_w, gla_gate_b, gla_norm_gain, w_out):
    B, S, _ = x.shape
    mod = c_act @ w_mod + b_mod
    shift, scale, gate = jnp.split(mod[:, None, :], 3, axis=-1)
    h = rms_norm(x, pre_gain) * (1.0 + scale) + shift
    proj = h @ w_in
    (aq, ak, av, ag, rq, rk, rv, rg, gq, gk, gv, gg, ga) = jnp.split(proj, IN_SPLITS, axis=-1)

    rope_freq = ROPE_THETA ** (-jnp.arange(0, HEAD_DIM, 2, dtype=jnp.float32) / HEAD_DIM)
    aq = apply_rotary(aq.reshape(B, S, ATTN_HEADS, HEAD_DIM), positions, rope_freq)
    ak = apply_rotary(ak.reshape(B, S, ATTN_KV_HEADS, HEAD_DIM), positions, rope_freq)
    av = av.reshape(B, S, ATTN_KV_HEADS, HEAD_DIM)
    a_out = sliding_window_attention(aq, ak, av, sinks) * jax.nn.silu(ag)

    ret_freq = 1.0 / (10000.0 ** jnp.linspace(0.0, 1.0, RET_DK // 2, dtype=jnp.float32))
    rq = apply_rotary(rq.reshape(B, S, RET_HEADS, RET_DK), positions, ret_freq)
    rk = apply_rotary(rk.reshape(B, S, RET_HEADS, RET_DK), positions, ret_freq)
    r = retention(rq, rk, rv.reshape(B, S, RET_HEADS, RET_DV))
    r_out = rms_norm(r).reshape(B, S, RET_W) * jax.nn.silu(rg)

    gate_logits = (ga @ gla_gate_w + gla_gate_b).astype(jnp.float32)
    log_a = (jax.nn.log_sigmoid(gate_logits) / GLA_GATE_NORMALIZER).reshape(B, S, GLA_HEADS, GLA_DK)
    g = gated_linear_attention(gq.reshape(B, S, GLA_HEADS, GLA_DK), gk.reshape(B, S, GLA_HEADS, GLA_DK),
                               gv.reshape(B, S, GLA_HEADS, GLA_DV), log_a)
    g_out = rms_norm(g, gla_norm_gain).reshape(B, S, GLA_W) * jax.nn.silu(gg)

    y = jnp.concatenate([a_out, r_out, g_out], axis=-1) @ w_out
    return x + gate * rms_norm(y, post_gain)


def setup_inputs(seed: int = 0) -> dict:
    key = jax.random.key(seed)
    ks = jax.random.split(key, 16)
    f32 = jnp.float32
    x = jax.random.normal(ks[0], (BATCH, SEQ, D_MODEL), f32)
    c = jax.random.normal(ks[1], (BATCH, D_MODEL), f32)
    positions = jnp.broadcast_to(jnp.arange(SEQ, dtype=jnp.int32)[None, :], (BATCH, SEQ))
    w_mod = jax.random.normal(ks[2], (DEPTH, D_MODEL, 3 * D_MODEL), f32) * (0.5 * D_MODEL ** -0.5)
    b_mod = jax.random.normal(ks[3], (DEPTH, 3 * D_MODEL), f32) * 0.01
    pre_norm_gain = 1.0 + 0.02 * jax.random.normal(ks[4], (DEPTH, D_MODEL), f32)
    post_norm_gain = 1.0 + 0.02 * jax.random.normal(ks[5], (DEPTH, D_MODEL), f32)
    w_in = jax.random.normal(ks[6], (DEPTH, D_MODEL, D_IN), f32) * (D_MODEL ** -0.5)
    attn_sinks = 0.5 * jax.random.normal(ks[7], (DEPTH, ATTN_HEADS), f32)
    gla_gate_w = jax.random.normal(ks[8], (DEPTH, GLA_GATE_RANK, GLA_HEADS * GLA_DK), f32) * (GLA_GATE_RANK ** -0.5)
    gla_gate_b = 0.01 * jax.random.normal(ks[9], (DEPTH, GLA_HEADS * GLA_DK), f32)
    gla_norm_gain = 1.0 + 0.02 * jax.random.normal(ks[10], (DEPTH, GLA_DV), f32)
    w_out = jax.random.normal(ks[11], (DEPTH, D_MIX, D_MODEL), f32) * (D_MIX ** -0.5)
    return {"x": x, "c": c, "positions": positions, "w_mod": w_mod, "b_mod": b_mod,
            "pre_norm_gain": pre_norm_gain, "post_norm_gain": post_norm_gain, "w_in": w_in,
            "attn_sinks": attn_sinks, "gla_gate_w": gla_gate_w, "gla_gate_b": gla_gate_b,
            "gla_norm_gain": gla_norm_gain, "w_out": w_out}


def reference(x, c, positions, w_mod, b_mod, pre_norm_gain, post_norm_gain, w_in,
              attn_sinks, gla_gate_w, gla_gate_b, gla_norm_gain, w_out):
    c_act = jax.nn.silu(c)
    for l in range(DEPTH):
        x = hybrid_layer(x, c_act, positions, w_mod[l], b_mod[l], pre_norm_gain[l], post_norm_gain[l],
                         w_in[l], attn_sinks[l], gla_gate_w[l], gla_gate_b[l], gla_norm_gain[l], w_out[l])
    return x
```

```cpp
#include <hip/hip_runtime.h>
#include <hip/hip_cooperative_groups.h>
#include <cstdio>
#include <cstdint>
namespace cg = cooperative_groups;

constexpr int NB = 8, SEQ = 2048, DM = 1024, DEPTH = 2, MROWS = NB * SEQ;
constexpr int DIN = 3088, NMAIN = 3072;
constexpr int PBLD = 3136, HLD = 1088, MLD = 1088;
constexpr int AQ = 0, AK = 512, AV = 640, AG = 768, RQ = 1280, RK = 1536, RV = 1792, RG = 2048, GQ = 2304, GK = 2432, GV = 2560, GG = 2816, GA = 3072;
constexpr float EPS = 1e-6f;
#ifndef PROBE_DUP
#define PROBE_DUP 0
#endif
constexpr int NTHREADS = 512, LDS_BYTES = 147456;
#define LAS __attribute__((address_space(3)))
extern __shared__ __attribute__((aligned(16))) unsigned char g_lds[];
constexpr int TM_OFF = LDS_BYTES - 32;
__device__ __forceinline__ int vcu_index() { int v = ((volatile LAS int*)((LAS unsigned char*)g_lds + TM_OFF))[1]; v = __builtin_amdgcn_readfirstlane(v); asm volatile("" : "+s"(v)); return v; }
__device__ __forceinline__ int vcu_from_block() { const int g = gridDim.x, bx = blockIdx.x; return (g % 8 == 0) ? (bx % 8) * (g / 8) + bx / 8 : bx; }

constexpr size_t WS_BAR = 0;
constexpr size_t WS_MOD = WS_BAR + 32768;
constexpr size_t WS_HB = WS_MOD + 196608;
constexpr size_t WS_WTIN = WS_HB + (size_t)MROWS * HLD * 2;
constexpr size_t WS_PB = WS_WTIN + (size_t)DEPTH * NMAIN * DM * 2;
constexpr size_t WS_MIXB = WS_PB + (size_t)MROWS * PBLD * 2;
constexpr size_t WS_X1B = WS_MIXB + (size_t)MROWS * MLD * 2;
constexpr size_t WS_WFOUT = WS_X1B + (size_t)MROWS * DM * 2;
constexpr size_t WS_URET = WS_WFOUT + (size_t)DEPTH * DM * DM * 2;
constexpr size_t WS_UGLA = WS_URET + (size_t)512 * 4096 * 4;
constexpr size_t WS_SRET = WS_UGLA + (size_t)1024 * 2048 * 4;
constexpr size_t WS_SGLA = WS_SRET + (size_t)512 * 4096 * 2;
constexpr size_t WS_BCUM = WS_SGLA + (size_t)1024 * 2048 * 2;
constexpr size_t WS_WFG = WS_BCUM + (size_t)MROWS * 128 * 4;
constexpr size_t WS_DGLA = WS_WFG + (size_t)DEPTH * 4 * 64 * 1024;
constexpr size_t WS_TOTAL = WS_DGLA + (size_t)1024 * 32 * 4;
struct Params {
    const float* x; const float* c; const int* pos; const float* w_mod; const float* b_mod;
    const float* pre_g; const float* post_g; const float* w_in; const float* sinks;
    const float* gate_w; const float* gate_b; const float* gla_g; const float* w_out;
    float* out; unsigned char* ws;
    __device__ __forceinline__ unsigned* bar() const { return (unsigned*)(ws + WS_BAR); }
    __device__ __forceinline__ float* mod() const { return (float*)(ws + WS_MOD); }
    __device__ __forceinline__ unsigned short* hb() const { return (unsigned short*)(ws + WS_HB); }
    __device__ __forceinline__ unsigned short* wt_in() const { return (unsigned short*)(ws + WS_WTIN); }
    __device__ __forceinline__ unsigned short* pb() const { return (unsigned short*)(ws + WS_PB); }
    __device__ __forceinline__ unsigned short* mixb() const { return (unsigned short*)(ws + WS_MIXB); }
    __device__ __forceinline__ unsigned short* x1b() const { return (unsigned short*)(ws + WS_X1B); }
    __device__ __forceinline__ unsigned short* wf_out() const { return (unsigned short*)(ws + WS_WFOUT); }
    __device__ __forceinline__ float* uret() const { return (float*)(ws + WS_URET); }
    __device__ __forceinline__ float* ugla() const { return (float*)(ws + WS_UGLA); }
    __device__ __forceinline__ unsigned short* sret() const { return (unsigned short*)(ws + WS_SRET); }
    __device__ __forceinline__ unsigned short* sgla() const { return (unsigned short*)(ws + WS_SGLA); }
    __device__ __forceinline__ float* bcum() const { return (float*)(ws + WS_BCUM); }
    __device__ __forceinline__ unsigned short* wfg() const { return (unsigned short*)(ws + WS_WFG); }
    __device__ __forceinline__ float* dgla() const { return (float*)(ws + WS_DGLA); }
};

typedef float f32x2_t __attribute__((ext_vector_type(2)));
typedef __bf16 bf16x2_t __attribute__((ext_vector_type(2)));
__device__ __forceinline__ unsigned pk2(float lo, float hi) { const f32x2_t v = {lo, hi}; return __builtin_bit_cast(unsigned, __builtin_convertvector(v, bf16x2_t)); }
__device__ __forceinline__ unsigned short f2bf(float f) { return (unsigned short)(pk2(f, 0.f) & 0xffffu); }
__device__ __forceinline__ float bf2f(unsigned short h) { return __uint_as_float(((unsigned)h) << 16); }
template <int CTRL, int ROWMASK> __device__ __forceinline__ float dpp_mov0(float v) { return __builtin_bit_cast(float, __builtin_amdgcn_update_dpp(0, __builtin_bit_cast(int, v), CTRL, ROWMASK, 0xf, true)); }
__device__ __forceinline__ float wave_sum(float v) {
    v += dpp_mov0<0xB1, 0xf>(v);
    v += dpp_mov0<0x4E, 0xf>(v);
    v += dpp_mov0<0x141, 0xf>(v);
    v += dpp_mov0<0x140, 0xf>(v);
    v += dpp_mov0<0x142, 0xa>(v);
    v += dpp_mov0<0x143, 0xc>(v);
    return __builtin_bit_cast(float, __builtin_amdgcn_readlane(__builtin_bit_cast(int, v), 63));
}
__device__ __forceinline__ float wave_max(float v) {
#pragma unroll
    for (int o = 1; o < 64; o <<= 1) v = fmaxf(v, __shfl_xor(v, o));
    return v;
}
__device__ __forceinline__ float silu(float v) { return v / (1.f + expf(-v)); }
__device__ __forceinline__ int phys_col(int c) { const bool rot = (c < 640) || (c >= 1280 && c < 1792); const int d = c & 63; return rot ? (c & ~63) + ((d < 32) ? 2 * d : 2 * (d - 32) + 1) : c; }
__device__ __forceinline__ int log_col(int pc) { const bool rot = (pc < 640) || (pc >= 1280 && pc < 1792); const int o = pc & 63; return rot ? (pc & ~63) + ((o & 1) ? 32 + (o >> 1) : (o >> 1)) : pc; }


namespace pg8 {
#define PG8_LAS __attribute__((address_space(3)))
typedef unsigned short bf16_t;
typedef short bf16x8 __attribute__((ext_vector_type(8)));
typedef float f32x4 __attribute__((ext_vector_type(4)));
typedef unsigned u32x4 __attribute__((ext_vector_type(4)));
constexpr int BM = 256, BK = 64, HALF = 128, HTB = HALF * BK * 2  , STAGE_BYTES = 8 * HTB, NXCD = 8, WGM = 8;

__host__ __device__ __forceinline__ int lds_byte(int r, int c) { const int st = (r >> 4) * 2 + (c >> 5), rr = r & 15, cc = c & 31, ob = rr * 64 + cc * 2; return st * 1024 + (ob ^ (((ob >> 9) & 1) << 5)); }
__host__ __device__ __forceinline__ void stage_rc(int b, int& R, int& C) { const int st = b / 1024, sb = b % 1024, swz = sb ^ (((sb >> 9) & 1) << 5); R = (st >> 1) * 16 + swz / 64; C = (st & 1) * 32 + (swz % 64) / 2; }
__host__ __device__ __forceinline__ int perm32(int rho) { const int n = rho >> 4, i = rho & 15; return 8 * (i >> 2) + 4 * n + (i & 3); }

struct Unit { int pm, pn; };
struct Gemm { const bf16_t* A; const bf16_t* Bt; int M, N, K, lda; };

struct StaticOrder {
    int nM, nN, nwg, G, c;
    __host__ __device__ void init(int M, int N, int G_, int c_) { nM = M / BM; nN = N / BM; nwg = nM * nN; G = G_; c = c_; }
    __host__ __device__ bool next(int i, Unit& u) const {
        const long L = (long)i * G + c; if (L >= nwg) return false;
        int wgid = (int)L; { const int q = nwg / NXCD, r = nwg % NXCD, xcd = wgid % NXCD, off = wgid / NXCD; wgid = (xcd < r ? xcd * (q + 1) : r * (q + 1) + (xcd - r) * q) + off; }
        const int nig = WGM * nN, gid = wgid / nig, fm = gid * WGM, gsz = (nM - fm) < WGM ? (nM - fm) : WGM;
        u.pm = fm + ((wgid % nig) % gsz); u.pn = (wgid % nig) / gsz; return true;
    }
    __device__ __forceinline__ void a_ready(const Unit&) const {}
    __device__ __forceinline__ void done(const Unit&) const {}
};
__device__ __forceinline__ unsigned cvt_pk_bf16(float lo, float hi) { unsigned r; asm volatile("v_cvt_pk_bf16_f32 %0, %1, %2" : "=v"(r) : "v"(lo), "v"(hi)); return r; }

struct EpiProj {
    static constexpr bool PERM = true, AFTER_DRAIN = false;
    bf16_t* O; const PG8_LAS int* posl;
    __device__ __forceinline__ static int rtype_of(int seg) { return (seg <= 4) ? 0 : ((seg >= 10 && seg <= 13) ? 1 : -1); }
    __device__ __forceinline__ static float scale_of(int seg) { return (seg <= 3 || seg == 12 || seg == 13) ? 0.125f : (seg == 18 ? 0.17677669529663687f : 1.0f); }
    __device__ __forceinline__ void operator()(const f32x4 (&acc)[2][2][4][2], const Unit& u, int slot, int, int, int) const {
        int t_ = threadIdx.x; asm volatile("" : "+v"(t_));
        const int wid = t_ >> 6, lane = t_ & 63, wr = wid >> 2, wc = wid & 3, fr = lane & 15, fq = lane >> 4;
        const int rl0 = wr * 64 + fr, row0 = u.pm * BM + rl0, col0 = u.pn * BM + wc * 32 + 8 * fq;
        const int ibase = 16 * (wc & 1) + 4 * fq;
        const int rt0 = rtype_of(u.pn * 2), rt1 = rtype_of(u.pn * 2 + 1), rt = rt0 >= 0 ? rt0 : rt1;
        const float sc0 = scale_of(u.pn * 2), sc1 = scale_of(u.pn * 2 + 1);
        float fv[4];
#pragma unroll
        for (int q = 0; q < 4; ++q) fv[q] = __builtin_amdgcn_exp2f(-(float)(ibase + q) * (rt == 1 ? 13.287712379549449f / 31.f : 13.287712379549449f / 32.f)) * 0.15915494309189535f;
#pragma unroll
        for (int it = 0; it < 8; ++it) {
            const int ai = it >> 2, m = it & 3;
            const int row = row0 + ai * HALF + m * 16;
            float cs[4], sn[4];
            if (rt >= 0) {
                const float pos = (float)posl[slot * 256 + rl0 + ai * HALF + m * 16];
#pragma unroll
                for (int q = 0; q < 4; ++q) { const float rev = pos * fv[q], fx = rev - __builtin_floorf(rev); cs[q] = __builtin_amdgcn_cosf(fx); sn[q] = __builtin_amdgcn_sinf(fx); }
            }
#pragma unroll
            for (int bj = 0; bj < 2; ++bj) {
                const bool rot = (bj == 0 ? rt0 : rt1) >= 0; const float sc = bj == 0 ? sc0 : sc1;
                f32x4 v0 = acc[ai][bj][m][0], v1 = acc[ai][bj][m][1];
                if (rot) {
                    f32x4 r0, r1;
                    r0[0] = v0[0] * cs[0] - v0[1] * sn[0]; r0[1] = v0[1] * cs[0] + v0[0] * sn[0];
                    r0[2] = v0[2] * cs[1] - v0[3] * sn[1]; r0[3] = v0[3] * cs[1] + v0[2] * sn[1];
                    r1[0] = v1[0] * cs[2] - v1[1] * sn[2]; r1[1] = v1[1] * cs[2] + v1[0] * sn[2];
                    r1[2] = v1[2] * cs[3] - v1[3] * sn[3]; r1[3] = v1[3] * cs[3] + v1[2] * sn[3];
                    v0 = r0; v1 = r1;
                }
                v0 = v0 * sc; v1 = v1 * sc;
                u32x4 w; w.x = cvt_pk_bf16(v0[0], v0[1]); w.y = cvt_pk_bf16(v0[2], v0[3]); w.z = cvt_pk_bf16(v1[0], v1[1]); w.w = cvt_pk_bf16(v1[2], v1[3]);
                *(u32x4*)(O + (size_t)row * PBLD + col0 + bj * HALF) = w;
            }
        }
    }
};
template <class Epi, class Sched>
__device__ __forceinline__ void gemm_phase(PG8_LAS unsigned char* lds, const Gemm g, const Sched& S, const Epi& E) {
    int tid_l = threadIdx.x; asm volatile("" : "+v"(tid_l));
    const int tid = tid_l, wid = __builtin_amdgcn_readfirstlane(tid >> 6), lane = tid & 63, wr = wid >> 2, wc = wid & 3, fr = lane & 15, fq = lane >> 4;
    const int K = g.K, nt = K / BK;
    unsigned voffA[2], voffB[2];
#pragma unroll
    for (int i = 0; i < 2; ++i) { int R, C; stage_rc(tid * 16 + i * 8192, R, C); const int Rb = Epi::PERM ? ((R & ~31) + perm32(R & 31)) : R;
        voffA[i] = (unsigned)(R * g.lda + C) * 2u; voffB[i] = (unsigned)(Rb * K + C) * 2u; }
    const size_t kstep = (size_t)(BK * 2);
    const size_t hstepA = (size_t)HALF * g.lda * 2, hstepB = (size_t)HALF * K * 2;
    const size_t tstepA = 2 * hstepA, tstepB = 2 * hstepB;
    const unsigned ldsw = (unsigned)wid * 1024u;
    const int aoff = lds_byte(wr * 64 + fr, fq * 8), boff = lds_byte(wc * 32 + fr, fq * 8);
#define PG8_SA(b, h) (((b) * 2 + (h)) * HTB)
#define PG8_SB(b, h) ((4 + (b) * 2 + (h)) * HTB)
#define PG8_STAGE(bufoff, gbase, voff) do { _Pragma("unroll") for (int _i = 0; _i < 2; ++_i) \
        __builtin_amdgcn_global_load_lds((const unsigned*)((const char*)(gbase) + (voff)[_i]), (PG8_LAS unsigned*)(lds + (bufoff) + ldsw + _i * 8192), 16, 0, 0); } while (0)
#define PG8_LDA(dst, b, h) do { _Pragma("unroll") for (int m = 0; m < 4; ++m) _Pragma("unroll") for (int k = 0; k < 2; ++k) dst[m][k] = *(const PG8_LAS bf16x8*)(lds + PG8_SA(b, h) + aoff + m * 2048 + k * 1024); } while (0)
#define PG8_LDB(dst, b, h) do { _Pragma("unroll") for (int n = 0; n < 2; ++n) _Pragma("unroll") for (int k = 0; k < 2; ++k) dst[n][k] = *(const PG8_LAS bf16x8*)(lds + PG8_SB(b, h) + boff + n * 2048 + k * 1024); } while (0)
#define PG8_MMA(ai, bj, At, Bt) do { __builtin_amdgcn_s_setprio(1); _Pragma("unroll") for (int m = 0; m < 4; ++m) _Pragma("unroll") for (int n = 0; n < 2; ++n) _Pragma("unroll") for (int k = 0; k < 2; ++k) \
        acc[ai][bj][m][n] = __builtin_amdgcn_mfma_f32_16x16x32_bf16(Bt[n][k], At[m][k], acc[ai][bj][m][n], 0, 0, 0); __builtin_amdgcn_s_setprio(0); } while (0)
#define PG8_WAIT_V(n) asm volatile("s_waitcnt vmcnt(" #n ")" ::: "memory")
#define PG8_WAIT_L(n) asm volatile("s_waitcnt lgkmcnt(" #n ")" ::: "memory")
#define PG8_BAR __builtin_amdgcn_s_barrier()
#define PG8_SCHED __builtin_amdgcn_sched_barrier(0)
    Unit cur, nxt; int ui = 0;
    if (!S.next(0, cur)) return;
    f32x4 acc[2][2][4][2];
#pragma unroll
    for (int a = 0; a < 2; ++a)
#pragma unroll
        for (int b = 0; b < 2; ++b)
#pragma unroll
            for (int m = 0; m < 4; ++m)
#pragma unroll
                for (int n = 0; n < 2; ++n) acc[a][b][m][n] = (f32x4){0.f, 0.f, 0.f, 0.f};
    bf16x8 At[4][2], B0[2][2], B1[2][2];
    const char* cA = (const char*)g.A + (size_t)cur.pm * tstepA; const char* cB = (const char*)g.Bt + (size_t)cur.pn * tstepB;
    S.a_ready(cur);
    PG8_STAGE(PG8_SB(0, 0), cB, voffB); PG8_STAGE(PG8_SA(0, 0), cA, voffA); PG8_STAGE(PG8_SB(0, 1), cB + hstepB, voffB); PG8_STAGE(PG8_SA(0, 1), cA + hstepA, voffA);
    if (wr == 1) PG8_BAR;
    PG8_WAIT_V(4); PG8_BAR;
    PG8_STAGE(PG8_SB(1, 0), cB + kstep, voffB); PG8_STAGE(PG8_SA(1, 0), cA + kstep, voffA); PG8_STAGE(PG8_SB(1, 1), cB + hstepB + kstep, voffB);
    PG8_WAIT_V(6); PG8_BAR;
    for (;;) {
        const bool has_next = S.next(ui + 1, nxt);
        const char* nA = has_next ? (const char*)g.A + (size_t)nxt.pm * tstepA : cA; const char* nB = has_next ? (const char*)g.Bt + (size_t)nxt.pn * tstepB : cB;
        for (int t = 0; t < nt; t += 2) {
            const bool last = (t == nt - 2);
            const char* a1 = cA + (size_t)(t + 1) * kstep;
            const char* a2 = last ? nA : cA + (size_t)(t + 2) * kstep; const char* b2 = last ? nB : cB + (size_t)(t + 2) * kstep;
            const char* a3 = a2 + kstep; const char* b3 = b2 + kstep;
            if (last && has_next) S.a_ready(nxt);
            PG8_LDB(B0, 0, 0); PG8_SCHED; PG8_LDA(At, 0, 0); PG8_STAGE(PG8_SA(1, 1), a1 + hstepA, voffA);
            PG8_WAIT_L(8); PG8_BAR; PG8_WAIT_L(0); PG8_MMA(0, 0, At, B0); PG8_BAR; PG8_SCHED;
            PG8_LDB(B1, 0, 1); PG8_STAGE(PG8_SB(0, 0), b2, voffB);
            PG8_BAR; PG8_WAIT_L(0); PG8_MMA(0, 1, At, B1); PG8_BAR;
            PG8_LDA(At, 0, 1); PG8_STAGE(PG8_SA(0, 0), a2, voffA);
            PG8_BAR; PG8_WAIT_L(0); PG8_MMA(1, 0, At, B0); PG8_BAR; PG8_SCHED;
            PG8_STAGE(PG8_SB(0, 1), b2 + hstepB, voffB);
            PG8_WAIT_V(6); PG8_BAR; PG8_MMA(1, 1, At, B1); PG8_BAR;
            PG8_LDB(B0, 1, 0); PG8_SCHED; PG8_LDA(At, 1, 0); PG8_STAGE(PG8_SA(0, 1), a2 + hstepA, voffA);
            PG8_WAIT_L(8); PG8_BAR; PG8_WAIT_L(0); PG8_MMA(0, 0, At, B0); PG8_BAR; PG8_SCHED;
            PG8_LDB(B1, 1, 1); PG8_STAGE(PG8_SB(1, 0), b3, voffB);
            PG8_BAR; PG8_WAIT_L(0); PG8_MMA(0, 1, At, B1); PG8_BAR;
            PG8_LDA(At, 1, 1); PG8_STAGE(PG8_SA(1, 0), a3, voffA);
            PG8_BAR; PG8_WAIT_L(0); PG8_MMA(1, 0, At, B0); PG8_BAR; PG8_SCHED;
            PG8_STAGE(PG8_SB(1, 1), b3 + hstepB, voffB);
            PG8_WAIT_V(6); PG8_BAR; PG8_MMA(1, 1, At, B1); PG8_BAR;
        }
        if constexpr (!Epi::AFTER_DRAIN) { E(acc, cur, ui, wc, fr, fq); S.done(cur); }
        if (!has_next) break;
#pragma unroll
        for (int a = 0; a < 2; ++a)
#pragma unroll
            for (int b = 0; b < 2; ++b)
#pragma unroll
                for (int m = 0; m < 4; ++m)
#pragma unroll
                    for (int n = 0; n < 2; ++n) acc[a][b][m][n] = (f32x4){0.f, 0.f, 0.f, 0.f};
        cur = nxt; cA = nA; cB = nB; ++ui;
    }
    PG8_WAIT_V(0);
    if (wr == 0) PG8_BAR;
    PG8_BAR;
    if constexpr (Epi::AFTER_DRAIN) { E.fused(acc, cur, wr, wc, fr, fq, lds, wid, lane); S.done(cur); }
#undef PG8_SA
#undef PG8_SB
#undef PG8_STAGE
#undef PG8_LDA
#undef PG8_LDB
#undef PG8_MMA
#undef PG8_WAIT_V
#undef PG8_WAIT_L
#undef PG8_BAR
#undef PG8_SCHED
}
}

__device__ __forceinline__ void phase_mod(const int tid_, const int bid_, const Params& p, float* smem) {
    float* sc = smem;
    float* red = smem + NB * DM;
    for (int i = tid_; i < NB * DM; i += NTHREADS) sc[i] = silu(p.c[i]);
    __syncthreads();
    const int wave = __builtin_amdgcn_readfirstlane(tid_ >> 6), lane = tid_ & 63, cl = lane & 31, kh = lane >> 5;
    const __amdgpu_buffer_rsrc_t wrs = __builtin_amdgcn_make_buffer_rsrc((void*)p.w_mod, 0, DEPTH * DM * 3 * DM * 4, 0x00020000);
    for (int grp = bid_; grp < DEPTH * 3 * DM / 32; grp += gridDim.x) {
        const int l = grp / (3 * DM / 32), j = (grp % (3 * DM / 32)) * 32 + cl, k0 = wave * 128 + kh * 64;
        const int voff = (kh * 64 * 3 * DM + j) * 4, soff = (l * DM + wave * 128) * 3 * DM * 4;
        float acc[NB];
#pragma unroll
        for (int b = 0; b < NB; ++b) acc[b] = 0.f;
#pragma unroll 1
        for (int hq = 0; hq < 2; ++hq) {
            float wv[32];
#pragma unroll
            for (int k = 0; k < 32; ++k) wv[k] = __builtin_bit_cast(float, __builtin_amdgcn_raw_buffer_load_b32(wrs, voff, soff + (hq * 32 + k) * 3 * DM * 4, 0));
#pragma unroll
            for (int kc = 0; kc < 8; ++kc) {
#pragma unroll
                for (int b = 0; b < NB; ++b) {
                    const float4 s0 = *(const float4*)&sc[b * DM + k0 + hq * 32 + 4 * kc];
                    acc[b] += s0.x * wv[4 * kc + 0] + s0.y * wv[4 * kc + 1] + s0.z * wv[4 * kc + 2] + s0.w * wv[4 * kc + 3];
                }
                asm volatile("" ::: "memory");
            }
        }
#pragma unroll
        for (int b = 0; b < NB; ++b) { acc[b] += __shfl_xor(acc[b], 32); if (kh == 0) red[(wave * NB + b) * 32 + cl] = acc[b]; }
        __syncthreads();
        if (tid_ < 256) {
            const int b = tid_ >> 5, c2 = tid_ & 31, j2 = (grp % (3 * DM / 32)) * 32 + c2;
            float t = p.b_mod[l * 3 * DM + j2];
#pragma unroll
            for (int w8 = 0; w8 < 8; ++w8) t += red[(w8 * NB + b) * 32 + c2];
            p.mod()[(size_t)(l * NB + b) * 3 * DM + j2] = t;
        }
        __syncthreads();
    }
    __syncthreads();
}

struct NormRows { float4 v[8][4]; };
template <int RA, int RB> __device__ __forceinline__ void norm_issue(const int tid_, const float* xin, int blk, NormRows& R) {
    const int lane = tid_ & 63, wv = tid_ >> 6;
#pragma unroll
    for (int r = RA; r < RB; ++r)
#pragma unroll
        for (int i = 0; i < 4; ++i) R.v[r][i] = *(const float4*)(xin + (size_t)(blk * 64 + wv * 8 + r) * DM + (lane + 64 * i) * 4);
}
template <int RA, int RB> __device__ __forceinline__ void norm_finish(const int tid_, const Params& p, int l, int blk, const NormRows& R) {
    const int lane = tid_ & 63, wv = tid_ >> 6;
    const int b = (blk * 64) / SEQ;
    const float* shift = p.mod() + (size_t)(l * NB + b) * 3 * DM;
    const float* scale = shift + DM;
    const float* g = p.pre_g + l * DM;
    float4 mg[4], ms[4];
#pragma unroll
    for (int i = 0; i < 4; ++i) { const int k = (lane + 64 * i) * 4;
        const float4 gg = *(const float4*)(g + k), sc = *(const float4*)(scale + k); ms[i] = *(const float4*)(shift + k);
        mg[i] = make_float4(gg.x * (1.f + sc.x), gg.y * (1.f + sc.y), gg.z * (1.f + sc.z), gg.w * (1.f + sc.w)); }
#pragma unroll
    for (int r = RA; r < RB; ++r) {
        const size_t row = (size_t)(blk * 64 + wv * 8 + r);
        float ss = 0.f;
#pragma unroll
        for (int i = 0; i < 4; ++i) ss += R.v[r][i].x * R.v[r][i].x + R.v[r][i].y * R.v[r][i].y + R.v[r][i].z * R.v[r][i].z + R.v[r][i].w * R.v[r][i].w;
        ss = wave_sum(ss);
        const float rstd = rsqrtf(ss * (1.f / DM) + EPS);
#pragma unroll
        for (int i = 0; i < 4; ++i) {
            const int k = (lane + 64 * i) * 4;
            uint2 o;
            o.x = pk2(R.v[r][i].x * rstd * mg[i].x + ms[i].x, R.v[r][i].y * rstd * mg[i].y + ms[i].y);
            o.y = pk2(R.v[r][i].z * rstd * mg[i].z + ms[i].z, R.v[r][i].w * rstd * mg[i].w + ms[i].w);
            *(uint2*)(p.hb() + row * HLD + k) = o;
        }
    }
}

__device__ __forceinline__ void p0_transpose_item(const float* W, int K, int ldw, unsigned short* WT, int N, LAS float* scr, int item, int lane) {
    const int nblk = N / 32, kb = item / nblk, nb = item % nblk, k0 = 64 * kb, n0 = 32 * nb;
#pragma unroll
    for (int hb2 = 0; hb2 < 2; ++hb2) {
        float tv[16];
#pragma unroll
        for (int i = 0; i < 16; ++i) tv[i] = W[(size_t)(k0 + 2 * (16 * hb2 + i) + (lane >> 5)) * ldw + log_col(n0 + (lane & 31))];
#pragma unroll
        for (int i = 0; i < 16; ++i) scr[(2 * (16 * hb2 + i) + (lane >> 5)) * 33 + (lane & 31)] = tv[i];
        asm volatile("" ::: "memory");
    }
    asm volatile("s_waitcnt lgkmcnt(0)" ::: "memory");
    const int c = lane & 7;
#pragma unroll
    for (int j = 0; j < 4; ++j) { const int n = (lane >> 3) + 8 * j; const LAS float* s = scr + (8 * c) * 33 + n;
        uint4 o; o.x = pk2(s[0 * 33], s[1 * 33]); o.y = pk2(s[2 * 33], s[3 * 33]); o.z = pk2(s[4 * 33], s[5 * 33]); o.w = pk2(s[6 * 33], s[7 * 33]);
        *(uint4*)(WT + (size_t)(n0 + n) * K + k0 + 8 * c) = o; }
    asm volatile("s_waitcnt lgkmcnt(0)" ::: "memory");
}
__device__ __forceinline__ void phase_wprep(const int tid_, const int bid_, const Params& p, LAS unsigned char* lds) {
    const int wave = tid_ >> 6, lane = tid_ & 63;
    LAS float* scr = (LAS float*)(lds + wave * 16384);
    const int gw = bid_ * (NTHREADS / 64) + wave, ngw = gridDim.x * (NTHREADS / 64);
    constexpr int ITEMS = (DM / 64) * (NMAIN / 32);
    for (int it = gw; it < DEPTH * ITEMS; it += ngw) {
        const int l = it / ITEMS, r = it % ITEMS;
        p0_transpose_item(p.w_in + (size_t)l * DM * DIN, DM, DIN, p.wt_in() + (size_t)l * NMAIN * DM, NMAIN, scr, r, lane);
    }
}
__device__ __forceinline__ void phase_wprep_out(const int tid_, const int bid_, const Params& p) {
#pragma unroll 2
    for (int idx = bid_ * blockDim.x + tid_; idx < DEPTH * 32 * 64 * 64; idx += gridDim.x * blockDim.x) {
        const int l = idx / (32 * 64 * 64), r = idx % (32 * 64 * 64), ct = r / (64 * 64), s = (r / 64) % 64, lane = r % 64;
        const float* W = p.w_out + (size_t)l * DM * DM + (size_t)(16 * s + 8 * (lane >> 5)) * DM + 32 * ct + (lane & 31);
        uint4 o;
        o.x = pk2(W[0 * DM], W[1 * DM]); o.y = pk2(W[2 * DM], W[3 * DM]); o.z = pk2(W[4 * DM], W[5 * DM]); o.w = pk2(W[6 * DM], W[7 * DM]);
        *(uint4*)(p.wf_out() + (size_t)idx * 8) = o;
    }
}

__device__ __forceinline__ void phase_wprep_fold(const int tid_, const int bid_, const Params& p) {
    for (int idx = bid_ * blockDim.x + tid_; idx < DEPTH * 4 * 64 * 64; idx += gridDim.x * blockDim.x) {
        const int l = idx / (4 * 64 * 64), r = idx % (4 * 64 * 64), ct = r / (64 * 64), s = (r / 64) % 64, lane = r % 64;
        const int n = 32 * ct + (lane & 31), k0 = 16 * s + 8 * (lane >> 5);
        float gw[16];
#pragma unroll
        for (int q = 0; q < 16; ++q) gw[q] = p.gate_w[(l * 16 + q) * 128 + n];
        float v[8];
#pragma unroll
        for (int j = 0; j < 8; ++j) {
            const float4* wr = (const float4*)(p.w_in + (size_t)l * DM * DIN + (size_t)(k0 + j) * DIN + GA);
            float a = 0.f;
#pragma unroll
            for (int q = 0; q < 4; ++q) { const float4 t4 = wr[q]; a += t4.x * gw[4 * q] + t4.y * gw[4 * q + 1] + t4.z * gw[4 * q + 2] + t4.w * gw[4 * q + 3]; }
            v[j] = a;
        }
        uint4 o; o.x = pk2(v[0], v[1]); o.y = pk2(v[2], v[3]); o.z = pk2(v[4], v[5]); o.w = pk2(v[6], v[7]);
        *(uint4*)(p.wfg() + (size_t)idx * 8) = o;
    }
}

namespace op4 {
typedef short bf16x8 __attribute__((ext_vector_type(8)));
typedef float f32x16 __attribute__((ext_vector_type(16)));
constexpr int AROW = 2064;
typedef unsigned mixu32x2 __attribute__((ext_vector_type(2)));
static_assert(64 * AROW + 8192 <= LDS_BYTES - 16, "P4 LDS map");
__device__ __forceinline__ void outproj_phase(LAS unsigned char* lds, const Params& p, int l, const float* xin) {
    int tid0 = threadIdx.x; asm volatile("" : "+v"(tid0));
    const int wid = __builtin_amdgcn_readfirstlane(tid0 >> 6);
    const __amdgpu_buffer_rsrc_t brs = __builtin_amdgcn_make_buffer_rsrc((void*)(p.wf_out() + (size_t)l * DM * DM), 0, DM * DM * 2, 0x00020000);
    for (int unit = vcu_index(); unit < MROWS / 64; unit += gridDim.x) {
        const int row0 = unit * 64, b = row0 / SEQ;
        int lane = tid0 & 63; asm volatile("" : "+v"(lane));
        const int c = lane & 31, hh = lane >> 5;
        {
            const unsigned short* Ag = p.mixb() + (size_t)row0 * MLD + lane * 8;
#pragma unroll
            for (int i = 0; i < 16; ++i) { const int r = wid * 8 + (i >> 1), half = i & 1;
                __builtin_amdgcn_global_load_lds((const unsigned*)(Ag + (size_t)r * MLD + half * 512), (LAS unsigned*)(lds + r * AROW + half * 1024), 16, 0, 0); }
        }
        const int bvoff = lane * 16, bsoff = wid * 4 * 65536;
        const int rot = (((int)blockIdx.x >> 3) * 2 + ((int)blockIdx.x & 1)) & 63;
#define OP4_LDB(nt, s) __builtin_bit_cast(bf16x8, __builtin_amdgcn_raw_buffer_load_b128(brs, bvoff, bsoff + (nt) * 65536 + (s) * 1024, 0))
        f32x16 acc[2][4];
#pragma unroll
        for (int mt = 0; mt < 2; ++mt)
#pragma unroll
            for (int nt = 0; nt < 4; ++nt)
#pragma unroll
                for (int i = 0; i < 16; ++i) acc[mt][nt][i] = 0.f;
        bf16x8 Bq[4][4];
#pragma unroll
        for (int u = 0; u < 4; ++u)
#pragma unroll
            for (int nt = 0; nt < 4; ++nt) Bq[u][nt] = OP4_LDB(nt, (u + rot) & 63);
        asm volatile("s_waitcnt vmcnt(0)" ::: "memory");
        __syncthreads();
        const LAS unsigned char* a0p = lds + c * AROW + hh * 16;
        const LAS unsigned char* a1p = lds + (32 + c) * AROW + hh * 16;
        for (int s0 = 0; s0 < 64; s0 += 4) {
#pragma unroll
            for (int u = 0; u < 4; ++u) {
                const int s = (s0 + u + rot) & 63, sn = (((s0 + u + 4 < 64) ? s0 + u + 4 : 63) + rot) & 63;
                const bf16x8 a0 = *(const LAS bf16x8*)(a0p + s * 32);
                const bf16x8 a1 = *(const LAS bf16x8*)(a1p + s * 32);
#pragma unroll
                for (int nt = 0; nt < 4; ++nt) {
                    acc[0][nt] = __builtin_amdgcn_mfma_f32_32x32x16_bf16(a0, Bq[u][nt], acc[0][nt], 0, 0, 0);
                    acc[1][nt] = __builtin_amdgcn_mfma_f32_32x32x16_bf16(a1, Bq[u][nt], acc[1][nt], 0, 0, 0);
                }
                __builtin_amdgcn_sched_barrier(0);
#pragma unroll
                for (int nt = 0; nt < 4; ++nt) Bq[u][nt] = OP4_LDB(nt, sn);
                __builtin_amdgcn_sched_barrier(0);
            }
        }
        __syncthreads();
        int lane2 = tid0 & 63; asm volatile("" : "+v"(lane2));
        {
            const int c2 = lane2 & 31, hh2 = lane2 >> 5;
            LAS unsigned short* yw = (LAS unsigned short*)(lds + (4 * hh2) * AROW) + 128 * wid + c2;
#pragma unroll
            for (int mt = 0; mt < 2; ++mt)
#pragma unroll
                for (int nt = 0; nt < 4; ++nt)
#pragma unroll
                    for (int i = 0; i < 16; ++i) yw[(32 * mt + (i & 3) + 8 * (i >> 2)) * (AROW / 2) + 32 * nt] = f2bf(acc[mt][nt][i]);
        }
        float4 xa[8][4];
        if (l == 0) {
#pragma unroll
            for (int rr = 0; rr < 8; ++rr)
#pragma unroll
                for (int j = 0; j < 4; ++j) xa[rr][j] = *(const float4*)(xin + (size_t)(row0 + wid * 8 + rr) * DM + (lane2 + 64 * j) * 4);
        } else {
#pragma unroll
            for (int rr = 0; rr < 8; ++rr)
#pragma unroll
                for (int j = 0; j < 4; ++j) { const mixu32x2 w = *(const mixu32x2*)(p.x1b() + (size_t)(row0 + wid * 8 + rr) * DM + (lane2 + 64 * j) * 4);
                    xa[rr][j] = make_float4(__uint_as_float(w.x << 16), __uint_as_float(w.x & 0xffff0000u), __uint_as_float(w.y << 16), __uint_as_float(w.y & 0xffff0000u)); }
        }
        float4 v1[4];
        LAS pg8::f32x4* pv2 = (LAS pg8::f32x4*)(lds + 64 * AROW);
        LAS pg8::f32x4* pv3 = pv2 + 256;
        if (l + 1 < DEPTH && tid0 < 256) {
            const float* md2 = p.mod() + (size_t)((l + 1) * NB + b) * 3 * DM;
            const float4 gg = *(const float4*)(p.pre_g + (l + 1) * DM + tid0 * 4), sh = *(const float4*)(md2 + tid0 * 4), sc = *(const float4*)(md2 + DM + tid0 * 4);
            pv2[tid0] = (pg8::f32x4){gg.x * (1.f + sc.x), gg.y * (1.f + sc.y), gg.z * (1.f + sc.z), gg.w * (1.f + sc.w)};
            pv3[tid0] = (pg8::f32x4){sh.x, sh.y, sh.z, sh.w};
        }
        {
            const float* gate = p.mod() + (size_t)(l * NB + b) * 3 * DM + 2 * DM;
            const float* pgp = p.post_g + l * DM;
#pragma unroll
            for (int j = 0; j < 4; ++j) { const int k = (lane2 + 64 * j) * 4;
                const float4 pg = *(const float4*)(pgp + k), gt = *(const float4*)(gate + k);
                v1[j] = make_float4(pg.x * gt.x, pg.y * gt.y, pg.z * gt.z, pg.w * gt.w); }
        }
        __syncthreads();
#pragma unroll
        for (int rr = 0; rr < 8; ++rr) {
            const int lr = wid * 8 + rr; const size_t go = (size_t)(row0 + lr) * DM;
            const LAS mixu32x2* yr = (const LAS mixu32x2*)(lds + lr * AROW);
            float yv[4][4]; float ss = 0.f;
#pragma unroll
            for (int j = 0; j < 4; ++j) { const mixu32x2 w = yr[lane2 + 64 * j];
                yv[j][0] = __uint_as_float(w.x << 16); yv[j][1] = __uint_as_float(w.x & 0xffff0000u); yv[j][2] = __uint_as_float(w.y << 16); yv[j][3] = __uint_as_float(w.y & 0xffff0000u);
                ss += yv[j][0] * yv[j][0] + yv[j][1] * yv[j][1] + yv[j][2] * yv[j][2] + yv[j][3] * yv[j][3]; }
            ss = wave_sum(ss);
            const float rstd = rsqrtf(ss * (1.f / DM) + EPS);
            float ss2 = 0.f; float4 xn[4];
#pragma unroll
            for (int j = 0; j < 4; ++j) { const int k = (lane2 + 64 * j) * 4;
                xn[j].x = xa[rr][j].x + v1[j].x * (yv[j][0] * rstd); xn[j].y = xa[rr][j].y + v1[j].y * (yv[j][1] * rstd);
                xn[j].z = xa[rr][j].z + v1[j].z * (yv[j][2] * rstd); xn[j].w = xa[rr][j].w + v1[j].w * (yv[j][3] * rstd);
                if (l + 1 < DEPTH) { mixu32x2 w; w.x = pk2(xn[j].x, xn[j].y); w.y = pk2(xn[j].z, xn[j].w); *(mixu32x2*)(p.x1b() + go + k) = w; }
                else *(float4*)(p.out + go + k) = xn[j];
                ss2 += xn[j].x * xn[j].x + xn[j].y * xn[j].y + xn[j].z * xn[j].z + xn[j].w * xn[j].w; }
            if (l + 1 < DEPTH) {
                ss2 = wave_sum(ss2);
                const float rstd2 = rsqrtf(ss2 * (1.f / DM) + EPS);
#pragma unroll
                for (int j = 0; j < 4; ++j) { const int k = (lane2 + 64 * j) * 4;
                    const pg8::f32x4 g2 = pv2[lane2 + 64 * j], s3 = pv3[lane2 + 64 * j];
                    uint2 o;
                    o.x = pk2(xn[j].x * rstd2 * g2[0] + s3[0], xn[j].y * rstd2 * g2[1] + s3[1]);
                    o.y = pk2(xn[j].z * rstd2 * g2[2] + s3[2], xn[j].w * rstd2 * g2[3] + s3[3]);
                    *(uint2*)(p.hb() + (size_t)(row0 + lr) * HLD + k) = o; }
            }
        }
        __syncthreads();
    }
}
#undef OP4_LDB
}

namespace mix {
typedef short bf16x8 __attribute__((ext_vector_type(8)));
typedef short s16x4 __attribute__((ext_vector_type(4)));
typedef float f32x16 __attribute__((ext_vector_type(16)));
typedef unsigned u32x4 __attribute__((ext_vector_type(4)));
typedef unsigned u32x2 __attribute__((ext_vector_type(2)));
typedef float f32x4 __attribute__((ext_vector_type(4)));
#define MFMA32(a, b, c) __builtin_amdgcn_mfma_f32_32x32x16_bf16((a), (b), (c), 0, 0, 0)
__device__ __forceinline__ bf16x8 lds_frag(const LAS unsigned char* p) { return *(const LAS bf16x8*)p; }
__device__ __forceinline__ bf16x8 lds_frag_perm(const LAS unsigned char* p) { const s16x4 lo = *(const LAS s16x4*)p, hi = *(const LAS s16x4*)(p + 16); return __builtin_shufflevector(lo, hi, 0, 1, 2, 3, 4, 5, 6, 7); }
template <int S_> __device__ __forceinline__ bf16x8 pack8(const f32x16& x) {
    u32x4 w; w.x = pk2(x[8 * S_ + 0], x[8 * S_ + 1]); w.y = pk2(x[8 * S_ + 2], x[8 * S_ + 3]); w.z = pk2(x[8 * S_ + 4], x[8 * S_ + 5]); w.w = pk2(x[8 * S_ + 6], x[8 * S_ + 7]);
    return __builtin_bit_cast(bf16x8, w);
}
__device__ __forceinline__ float fsilu(float v) { return v * __builtin_amdgcn_rcpf(1.f + __expf(-v)); }

constexpr int A_KP = 144, A_VTP = 528, A_OP = 528;
constexpr int A_K = 0, A_VT = 256 * A_KP, A_O = A_VT + 64 * A_VTP, A_END = A_O + 128 * A_OP;
static_assert(A_END <= LDS_BYTES, "attention LDS map");
__device__ __forceinline__ void attn_phase(LAS unsigned char* lds, const Params& p, int l) {
    int tid = threadIdx.x; asm volatile("" : "+v"(tid));
    const int wid = __builtin_amdgcn_readfirstlane(tid >> 6), lane = tid & 63, c = lane & 31, hh = lane >> 5;
    for (int unit = vcu_index(); unit < NB * 2 * 16; unit += gridDim.x) {
        const int qb = unit & 15, kvh = (unit >> 4) & 1, b = unit >> 5;
        const size_t R0 = (size_t)b * SEQ + qb * 128;
        const int g = wid >> 1, rh = wid & 1, h = kvh * 4 + g;
        bf16x8 qfa[2][4];
#pragma unroll
        for (int rg = 0; rg < 2; ++rg) { const unsigned short* qsrc = p.pb() + (R0 + rh * 64 + rg * 32 + c) * PBLD + AQ + h * 64 + 8 * hh;
#pragma unroll
            for (int s = 0; s < 4; ++s) qfa[rg][s] = *(const bf16x8*)(qsrc + 16 * s); }
#pragma unroll
        for (int i = 0; i < 4; ++i) {
            const int id = tid + 512 * i, key = id >> 3, part = id & 7;
            long kr = (long)R0 - 128 + key; if (kr < (long)b * SEQ) kr = (long)b * SEQ;
            const unsigned short* srow = p.pb() + (size_t)kr * PBLD;
            const u32x4 kv = *(const u32x4*)(srow + AK + kvh * 64 + part * 8);
            const u32x4 vv = *(const u32x4*)(srow + AV + kvh * 64 + part * 8);
            *(LAS u32x4*)(lds + A_K + key * A_KP + part * 16) = kv;
            LAS unsigned short* vt = (LAS unsigned short*)(lds + A_VT + (part * 8) * A_VTP) + key;
            vt[0 * (A_VTP / 2)] = (unsigned short)(vv.x & 0xffffu); vt[1 * (A_VTP / 2)] = (unsigned short)(vv.x >> 16);
            vt[2 * (A_VTP / 2)] = (unsigned short)(vv.y & 0xffffu); vt[3 * (A_VTP / 2)] = (unsigned short)(vv.y >> 16);
            vt[4 * (A_VTP / 2)] = (unsigned short)(vv.z & 0xffffu); vt[5 * (A_VTP / 2)] = (unsigned short)(vv.z >> 16);
            vt[6 * (A_VTP / 2)] = (unsigned short)(vv.w & 0xffffu); vt[7 * (A_VTP / 2)] = (unsigned short)(vv.w >> 16);
        }
        __syncthreads();
        const float sink = p.sinks[l * 8 + h];
#pragma unroll
        for (int rg = 0; rg < 2; ++rg) {
            const int r0 = rh * 64 + rg * 32, m = r0 >> 5;
            bf16x8 qf[4];
#pragma unroll
            for (int s = 0; s < 4; ++s) qf[s] = qfa[rg][s];
            f32x16 st[5];
#pragma unroll
            for (int t = 0; t < 5; ++t) {
#pragma unroll
                for (int i = 0; i < 16; ++i) st[t][i] = 0.f;
#pragma unroll
                for (int s = 0; s < 4; ++s) st[t] = MFMA32(lds_frag(lds + A_K + ((m + t) * 32 + c) * A_KP + (16 * s + 8 * hh) * 2), qf[s], st[t]);
            }
            float mx = sink;
#pragma unroll
            for (int t = 0; t < 5; ++t) {
                const bool tile_ok = (qb > 0) || (m + t >= 4);
#pragma unroll
                for (int i = 0; i < 16; ++i) {
                    const int kl = (i & 3) + 8 * (i >> 2) + 4 * hh;
                    const bool valid = tile_ok && (t == 0 ? (kl > c) : (t == 4 ? (kl <= c) : true));
                    st[t][i] = valid ? st[t][i] : -1e30f;
                    mx = fmaxf(mx, st[t][i]);
                }
            }
            mx = fmaxf(mx, __shfl_xor(mx, 32));
            float sum = 0.f;
            const float mxl = mx * 1.4426950408889634f;
#pragma unroll
            for (int t = 0; t < 5; ++t)
#pragma unroll
                for (int i = 0; i < 16; ++i) { const float e = __builtin_amdgcn_exp2f(st[t][i] * 1.4426950408889634f - mxl); st[t][i] = e; sum += e; }
            sum += __shfl_xor(sum, 32);
            sum += __expf(sink - mx);
            const float inv = __builtin_amdgcn_rcpf(sum);
            f32x16 ot[2];
#pragma unroll
            for (int dt = 0; dt < 2; ++dt)
#pragma unroll
                for (int i = 0; i < 16; ++i) ot[dt][i] = 0.f;
#pragma unroll
            for (int t = 0; t < 5; ++t) {
                const bf16x8 p0 = pack8<0>(st[t]), p1 = pack8<1>(st[t]);
#pragma unroll
                for (int dt = 0; dt < 2; ++dt) {
                    const LAS unsigned char* vp = lds + A_VT + (32 * dt + c) * A_VTP + ((m + t) * 32 + 4 * hh) * 2;
                    ot[dt] = MFMA32(lds_frag_perm(vp), p0, ot[dt]);
                    ot[dt] = MFMA32(lds_frag_perm(vp + 32), p1, ot[dt]);
                }
            }
#pragma unroll
            for (int dt = 0; dt < 2; ++dt)
#pragma unroll
                for (int q4 = 0; q4 < 4; ++q4) {
                    u32x2 w; w.x = pk2(ot[dt][4 * q4 + 0] * inv, ot[dt][4 * q4 + 1] * inv); w.y = pk2(ot[dt][4 * q4 + 2] * inv, ot[dt][4 * q4 + 3] * inv);
                    *(LAS u32x2*)(lds + A_O + (r0 + c) * A_OP + (g * 64 + 32 * dt + 8 * q4 + 4 * hh) * 2) = w;
                }
        }
        u32x4 gate8[8];
#pragma unroll
        for (int i = 0; i < 8; ++i) { const int id = tid + 512 * i, row = id >> 5, part = id & 31;
            gate8[i] = *(const u32x4*)(p.pb() + (R0 + row) * PBLD + AG + kvh * 256 + part * 8); }
        __syncthreads();
#pragma unroll
        for (int i = 0; i < 8; ++i) {
            const int id = tid + 512 * i, row = id >> 5, part = id & 31;
            const u32x4 o8 = *(const LAS u32x4*)(lds + A_O + row * A_OP + part * 16);
            const u32x4 g8 = gate8[i];
            u32x4 r;
#pragma unroll
            for (int j = 0; j < 4; ++j) {
                const float o0 = __uint_as_float(o8[j] << 16), o1 = __uint_as_float(o8[j] & 0xffff0000u);
                const float g0 = __uint_as_float(g8[j] << 16), g1 = __uint_as_float(g8[j] & 0xffff0000u);
                r[j] = pk2(o0 * fsilu(g0), o1 * fsilu(g1));
            }
            *(u32x4*)(p.mixb() + (R0 + row) * MLD + kvh * 256 + part * 8) = r;
        }
        __syncthreads();
    }
}

constexpr int R_P128 = 272, R_P64 = 144;
constexpr int RU_VT = 0, RU_KT = 64 * R_P128, RU_GRP = 2 * 64 * R_P128;
static_assert(2 * RU_GRP <= LDS_BYTES, "ret U LDS map");
__device__ __forceinline__ void scatter8(LAS unsigned char* base, int pitch, int row0, int col, const u32x4 v) {
    LAS unsigned short* t = (LAS unsigned short*)(base + row0 * pitch) + col; const int ps = pitch / 2;
    t[0 * ps] = (unsigned short)(v.x & 0xffffu); t[1 * ps] = (unsigned short)(v.x >> 16); t[2 * ps] = (unsigned short)(v.y & 0xffffu); t[3 * ps] = (unsigned short)(v.y >> 16);
    t[4 * ps] = (unsigned short)(v.z & 0xffffu); t[5 * ps] = (unsigned short)(v.z >> 16); t[6 * ps] = (unsigned short)(v.w & 0xffffu); t[7 * ps] = (unsigned short)(v.w >> 16);
}
__device__ __forceinline__ u32x4 scale8(const u32x4 v, float f) {
    u32x4 r;
#pragma unroll
    for (int j = 0; j < 4; ++j) r[j] = pk2(__uint_as_float(v[j] << 16) * f, __uint_as_float(v[j] & 0xffff0000u) * f);
    return r;
}
__device__ __forceinline__ void ret_u_phase(LAS unsigned char* lds, const Params& p) {
    int tid = threadIdx.x; asm volatile("" : "+v"(tid));
    const int wid = __builtin_amdgcn_readfirstlane(tid >> 6), lane = tid & 63, c = lane & 31, hh = lane >> 5, grp = wid >> 2, wl = wid & 3, tg = tid & 255;
    for (int unit = vcu_index(); unit < 256; unit += gridDim.x) {
        const int hp = unit & 1, ch = (unit >> 1) & 15, b = unit >> 5, h = 2 * hp + grp;
        const size_t T0 = (size_t)b * SEQ + ch * 128;
        const float l2g = log2f(1.f - __builtin_amdgcn_exp2f(-5.f - (float)h));
        LAS unsigned char* G = lds + grp * RU_GRP;
#pragma unroll
        for (int i = 0; i < 4; ++i) {
            const int id = tg + 256 * i, j = id >> 3, part = id & 7;
            const unsigned short* srow = p.pb() + (T0 + j) * PBLD;
            const u32x4 kv = *(const u32x4*)(srow + RK + h * 64 + part * 8);
            const u32x4 vv = *(const u32x4*)(srow + RV + h * 64 + part * 8);
            scatter8(G + RU_KT, R_P128, part * 8, j, scale8(kv, __builtin_amdgcn_exp2f((float)(127 - j) * l2g)));
            scatter8(G + RU_VT, R_P128, part * 8, j, vv);
        }
        __syncthreads();
        const int vt = wl >> 1, dt = wl & 1;
        f32x16 acc;
#pragma unroll
        for (int i = 0; i < 16; ++i) acc[i] = 0.f;
#pragma unroll
        for (int s = 0; s < 8; ++s)
            acc = MFMA32(lds_frag(G + RU_VT + (32 * vt + c) * R_P128 + (16 * s + 8 * hh) * 2), lds_frag(G + RU_KT + (32 * dt + c) * R_P128 + (16 * s + 8 * hh) * 2), acc);
        float* ug = p.uret() + ((size_t)((b * 4 + h) * 16 + ch)) * 4096 + 32 * dt + c;
#pragma unroll
        for (int i = 0; i < 16; ++i) ug[(32 * vt + (i & 3) + 8 * (i >> 2) + 4 * hh) * 64] = acc[i];
        __syncthreads();
    }
}
constexpr int RO_K = 0, RO_VT = 128 * R_P64, RO_ST = RO_VT + 64 * R_P128, RO_OUT = RO_ST + 64 * R_P64, RO_GRP = RO_OUT + 128 * R_P64;
static_assert(2 * RO_GRP <= LDS_BYTES, "ret out LDS map");
__device__ __forceinline__ void ret_out_phase(LAS unsigned char* lds, const Params& p) {
    int tid = threadIdx.x; asm volatile("" : "+v"(tid));
    const int wid = __builtin_amdgcn_readfirstlane(tid >> 6), lane = tid & 63, c = lane & 31, hh = lane >> 5, grp = wid >> 2, it = wid & 3, tg = tid & 255;
    for (int unit = vcu_index(); unit < 256; unit += gridDim.x) {
        const int hp = unit & 1, ch = (unit >> 1) & 15, b = unit >> 5, h = 2 * hp + grp;
        const size_t T0 = (size_t)b * SEQ + ch * 128;
        const float gam = 1.f - __builtin_amdgcn_exp2f(-5.f - (float)h), l2g = log2f(gam);
        LAS unsigned char* G = lds + grp * RO_GRP;
        const int il = 32 * it + c;
        bf16x8 qf[4];
        { const unsigned short* qsrc = p.pb() + (T0 + il) * PBLD + RQ + h * 64 + 8 * hh;
#pragma unroll
          for (int s = 0; s < 4; ++s) qf[s] = *(const bf16x8*)(qsrc + 16 * s); }
#pragma unroll
        for (int i = 0; i < 4; ++i) {
            const int id = tg + 256 * i, j = id >> 3, part = id & 7;
            const unsigned short* srow = p.pb() + (T0 + j) * PBLD;
            const u32x4 kv = *(const u32x4*)(srow + RK + h * 64 + part * 8);
            const u32x4 vv = *(const u32x4*)(srow + RV + h * 64 + part * 8);
            *(LAS u32x4*)(G + RO_K + j * R_P64 + part * 16) = kv;
            scatter8(G + RO_VT, R_P128, part * 8, j, vv);
        }
#pragma unroll
        for (int i = 0; i < 2; ++i) { const int id = tg + 256 * i, v = id >> 3, part = id & 7;
            *(LAS u32x4*)(G + RO_ST + v * R_P64 + part * 16) = *(const u32x4*)(p.sret() + ((size_t)((b * 4 + h) * 16 + ch)) * 4096 + v * 64 + part * 8); }
        __syncthreads();
        f32x16 acc[2];
#pragma unroll
        for (int vt = 0; vt < 2; ++vt) {
#pragma unroll
            for (int i = 0; i < 16; ++i) acc[vt][i] = 0.f;
#pragma unroll
            for (int s = 0; s < 4; ++s) acc[vt] = MFMA32(lds_frag(G + RO_ST + (32 * vt + c) * R_P64 + (16 * s + 8 * hh) * 2), qf[s], acc[vt]);
        }
        const float gi = __builtin_amdgcn_exp2f((float)il * l2g);
#pragma unroll
        for (int vt = 0; vt < 2; ++vt)
#pragma unroll
            for (int i = 0; i < 16; ++i) acc[vt][i] *= gi;
#pragma unroll 1
        for (int jt = 0; jt <= it; ++jt) {
            f32x16 st;
#pragma unroll
            for (int i = 0; i < 16; ++i) st[i] = 0.f;
#pragma unroll
            for (int s = 0; s < 4; ++s) st = MFMA32(lds_frag(G + RO_K + (32 * jt + c) * R_P64 + (16 * s + 8 * hh) * 2), qf[s], st);
#pragma unroll
            for (int i = 0; i < 16; ++i) { const int jl = 32 * jt + (i & 3) + 8 * (i >> 2) + 4 * hh, dlt = il - jl;
                st[i] = dlt >= 0 ? st[i] * __builtin_amdgcn_exp2f((float)dlt * l2g) : 0.f; }
            const bf16x8 p0 = pack8<0>(st), p1 = pack8<1>(st);
#pragma unroll
            for (int vt = 0; vt < 2; ++vt) {
                const LAS unsigned char* vp = G + RO_VT + (32 * vt + c) * R_P128 + (32 * jt + 4 * hh) * 2;
                acc[vt] = MFMA32(lds_frag_perm(vp), p0, acc[vt]);
                acc[vt] = MFMA32(lds_frag_perm(vp + 32), p1, acc[vt]);
            }
        }
        float ss = 0.f;
#pragma unroll
        for (int vt = 0; vt < 2; ++vt)
#pragma unroll
            for (int i = 0; i < 16; ++i) ss += acc[vt][i] * acc[vt][i];
        ss += __shfl_xor(ss, 32);
        const float rstd = rsqrtf(ss * (1.f / 64.f) + EPS);
#pragma unroll
        for (int vt = 0; vt < 2; ++vt)
#pragma unroll
            for (int q4 = 0; q4 < 4; ++q4) {
                u32x2 w; w.x = pk2(acc[vt][4 * q4 + 0] * rstd, acc[vt][4 * q4 + 1] * rstd); w.y = pk2(acc[vt][4 * q4 + 2] * rstd, acc[vt][4 * q4 + 3] * rstd);
                *(LAS u32x2*)(G + RO_OUT + il * R_P64 + (32 * vt + 8 * q4 + 4 * hh) * 2) = w;
            }
        u32x4 gate4[4];
#pragma unroll
        for (int i = 0; i < 4; ++i) { const int id = tg + 256 * i, row = id >> 3, part = id & 7; gate4[i] = *(const u32x4*)(p.pb() + (T0 + row) * PBLD + RG + h * 64 + part * 8); }
        __syncthreads();
#pragma unroll
        for (int i = 0; i < 4; ++i) {
            const int id = tg + 256 * i, row = id >> 3, part = id & 7;
            const u32x4 o8 = *(const LAS u32x4*)(G + RO_OUT + row * R_P64 + part * 16);
            const u32x4 g8 = gate4[i];
            u32x4 r;
#pragma unroll
            for (int j = 0; j < 4; ++j) {
                const float o0 = __uint_as_float(o8[j] << 16), o1 = __uint_as_float(o8[j] & 0xffff0000u);
                const float g0 = __uint_as_float(g8[j] << 16), g1 = __uint_as_float(g8[j] & 0xffff0000u);
                r[j] = pk2(o0 * fsilu(g0), o1 * fsilu(g1));
            }
            *(u32x4*)(p.mixb() + (T0 + row) * MLD + 512 + h * 64 + part * 8) = r;
        }
        __syncthreads();
    }
}

constexpr int G_P32 = 80, G_P64 = 144, G_BP = 33;
constexpr int GU_BT = 0, GU_VT = 64 * G_BP * 4, GU_KT = GU_VT + 64 * G_P64, GU_HEAD = GU_KT + 32 * G_P64, GU_AROW = 2064;
constexpr int GU_XCH = 4 * GU_HEAD;
static_assert(64 * GU_AROW <= LDS_BYTES && GU_XCH + 32768 <= LDS_BYTES - 16, "gla logits LDS map");
static_assert(4 * GU_HEAD <= LDS_BYTES, "gla U LDS map");
__device__ __forceinline__ u32x4 scale8v(const u32x4 v, const float* f) {
    u32x4 r;
#pragma unroll
    for (int j = 0; j < 4; ++j) r[j] = pk2(__uint_as_float(v[j] << 16) * f[2 * j], __uint_as_float(v[j] & 0xffff0000u) * f[2 * j + 1]);
    return r;
}
__device__ __forceinline__ void gla_logits_job(LAS unsigned char* lds, const Params& p, int l) {
    int tid = threadIdx.x; asm volatile("" : "+v"(tid));
    const int wid = __builtin_amdgcn_readfirstlane(tid >> 6), lane = tid & 63, c = lane & 31, hh = lane >> 5, h = wid >> 1, vt = wid & 1, th = tid & 127;
    const __amdgpu_buffer_rsrc_t wrs = __builtin_amdgcn_make_buffer_rsrc((void*)(p.wfg() + (size_t)l * 4 * 64 * 512), 0, 4 * 64 * 1024, 0x00020000);
    for (int unit = vcu_index(); unit < 256; unit += gridDim.x) {
        const int ch = unit & 31, b = unit >> 5;
        const size_t T0 = (size_t)b * SEQ + ch * 64;
        LAS unsigned char* H = lds + h * GU_HEAD;
        LAS float* bt = (LAS float*)(H + GU_BT);
        {
            const int kh = wid >> 2, nt = wid & 3;
            {
                const unsigned short* Ag = p.hb() + T0 * HLD + lane * 8;
#pragma unroll
                for (int i = 0; i < 16; ++i) { const int r = wid * 8 + (i >> 1), half = i & 1;
                    __builtin_amdgcn_global_load_lds((const unsigned*)(Ag + (size_t)r * HLD + half * 512), (LAS unsigned*)(lds + r * GU_AROW + half * 1024), 16, 0, 0); }
            }
            const int bso = nt * 65536 + kh * 32768;
            bf16x8 rb[16];
#pragma unroll
            for (int u = 0; u < 16; ++u) rb[u] = __builtin_bit_cast(bf16x8, __builtin_amdgcn_raw_buffer_load_b128(wrs, lane * 16, bso + u * 1024, 0));
            asm volatile("s_waitcnt vmcnt(0)" ::: "memory");
            __syncthreads();
            const LAS unsigned char* apl = lds + c * GU_AROW + hh * 16 + kh * 1024;
            f32x16 lg0, lg1;
#pragma unroll
            for (int i = 0; i < 16; ++i) { lg0[i] = 0.f; lg1[i] = 0.f; }
            for (int s0 = 0; s0 < 32; s0 += 16) {
#pragma unroll
                for (int u = 0; u < 16; ++u) {
                    const int s = s0 + u, sn = (s + 16 < 32) ? s + 16 : 31;
                    lg0 = MFMA32(*(const LAS bf16x8*)(apl + s * 32), rb[u], lg0);
                    lg1 = MFMA32(*(const LAS bf16x8*)(apl + 32 * GU_AROW + s * 32), rb[u], lg1);
                    __builtin_amdgcn_sched_barrier(0);
                    rb[u] = __builtin_bit_cast(bf16x8, __builtin_amdgcn_raw_buffer_load_b128(wrs, lane * 16, bso + sn * 1024, 0));
                    __builtin_amdgcn_sched_barrier(0);
                }
            }
            __syncthreads();
            LAS float* xr = (LAS float*)(lds + GU_XCH) + (nt * 32) * 64 + lane;
            if (kh == 1) {
#pragma unroll
                for (int i = 0; i < 16; ++i) { xr[i * 64] = lg0[i]; xr[(16 + i) * 64] = lg1[i]; }
            }
            __syncthreads();
            if (kh == 0) {
                const float gb = p.gate_b[l * 128 + 32 * nt + c];
                LAS float* btn = (LAS float*)(lds + nt * GU_HEAD + GU_BT);
#pragma unroll
                for (int i = 0; i < 16; ++i) {
                    const float x0 = lg0[i] + xr[i * 64] + gb, x1 = lg1[i] + xr[(16 + i) * 64] + gb;
                    const int r = (i & 3) + 8 * (i >> 2) + 4 * hh;
                    btn[r * G_BP + c] = (fminf(x0, 0.f) - __logf(1.f + __expf(-fabsf(x0)))) * (1.f / 16.f);
                    btn[(32 + r) * G_BP + c] = (fminf(x1, 0.f) - __logf(1.f + __expf(-fabsf(x1)))) * (1.f / 16.f);
                }
            }
        }
        __syncthreads();
        {
            const int d = th & 31, seg = th >> 5;
            LAS float* tot = (LAS float*)(H + GU_VT);
            float v[16]; float a = 0.f;
#pragma unroll
            for (int i = 0; i < 16; ++i) v[i] = bt[(16 * seg + i) * G_BP + d];
#pragma unroll
            for (int i = 0; i < 16; ++i) { a += v[i]; v[i] = a; }
            tot[seg * 32 + d] = a;
            __syncthreads();
            float off = 0.f;
#pragma unroll
            for (int q = 0; q < 3; ++q) off += (q < seg) ? tot[q * 32 + d] : 0.f;
#pragma unroll
            for (int i = 0; i < 16; ++i) bt[(16 * seg + i) * G_BP + d] = v[i] + off;
        }
        __syncthreads();
        {
#pragma unroll
            for (int i = 0; i < 16; ++i) { const int id = tid + 512 * i, row = id >> 7, col = id & 127;
                p.bcum()[(T0 + row) * 128 + col] = ((const LAS float*)(lds + (col >> 5) * GU_HEAD + GU_BT))[row * G_BP + (col & 31)]; }
        }
        __syncthreads();
    }
}
__device__ __forceinline__ void gla_u_phase(LAS unsigned char* lds, const Params& p, int l) {
    int tid = threadIdx.x; asm volatile("" : "+v"(tid));
    const int wid = __builtin_amdgcn_readfirstlane(tid >> 6), lane = tid & 63, c = lane & 31, hh = lane >> 5, h = wid >> 1, vt = wid & 1, th = tid & 127;
    for (int unit = vcu_index(); unit < 256; unit += gridDim.x) {
        const int ch = unit & 31, b = unit >> 5;
        const size_t T0 = (size_t)b * SEQ + ch * 64;
        LAS unsigned char* H = lds + h * GU_HEAD;
        LAS float* bt = (LAS float*)(H + GU_BT);
#pragma unroll
        for (int i = 0; i < 4; ++i) { const int id = th + 128 * i, row = id >> 3, part = id & 7;
            const f32x4 bv = *(const f32x4*)(p.bcum() + (T0 + row) * 128 + h * 32 + part * 4);
            bt[row * G_BP + part * 4 + 0] = bv[0]; bt[row * G_BP + part * 4 + 1] = bv[1]; bt[row * G_BP + part * 4 + 2] = bv[2]; bt[row * G_BP + part * 4 + 3] = bv[3]; }
        __syncthreads();
#pragma unroll
        for (int i = 0; i < 4; ++i) { const int id = th + 128 * i, j = id >> 3, part = id & 7;
            const u32x4 vv = *(const u32x4*)(p.pb() + (T0 + j) * PBLD + GV + h * 64 + part * 8);
            scatter8(H + GU_VT, G_P64, part * 8, j, vv); }
#pragma unroll
        for (int i = 0; i < 2; ++i) { const int id = th + 128 * i, j = id >> 2, part = id & 3;
            const u32x4 kv = *(const u32x4*)(p.pb() + (T0 + j) * PBLD + GK + h * 32 + part * 8);
            float f[8];
#pragma unroll
            for (int e = 0; e < 8; ++e) f[e] = __expf(-bt[j * G_BP + part * 8 + e]);
            scatter8(H + GU_KT, G_P64, part * 8, j, scale8v(kv, f)); }
        __syncthreads();
        f32x16 acc;
#pragma unroll
        for (int i = 0; i < 16; ++i) acc[i] = 0.f;
#pragma unroll
        for (int s = 0; s < 4; ++s)
            acc = MFMA32(lds_frag(H + GU_VT + (32 * vt + c) * G_P64 + (16 * s + 8 * hh) * 2), lds_frag(H + GU_KT + c * G_P64 + (16 * s + 8 * hh) * 2), acc);
        const float dl = __expf(bt[63 * G_BP + c]);
        const size_t ui = (size_t)((b * 4 + h) * 32 + ch);
        float* ug = p.ugla() + ui * 2048 + c;
#pragma unroll
        for (int i = 0; i < 16; ++i) ug[(32 * vt + (i & 3) + 8 * (i >> 2) + 4 * hh) * 32] = acc[i] * dl;
        if (vt == 0 && hh == 0) p.dgla()[ui * 32 + c] = dl;
        __syncthreads();
    }
}
constexpr int GO_BT = 0, GO_KS = 64 * G_BP * 4, GO_VT = GO_KS + 64 * G_P32, GO_ST = GO_VT + 64 * G_P64, GO_HEAD = GO_ST + 64 * G_P32;
static_assert(4 * GO_HEAD <= LDS_BYTES, "gla out LDS map");
__device__ __forceinline__ void gla_out_phase(LAS unsigned char* lds, const Params& p, int l) {
    int tid = threadIdx.x; asm volatile("" : "+v"(tid));
    const int wid = __builtin_amdgcn_readfirstlane(tid >> 6), lane = tid & 63, c = lane & 31, hh = lane >> 5, h = wid >> 1, it = wid & 1, th = tid & 127;
    for (int unit = vcu_index(); unit < 256; unit += gridDim.x) {
        const int ch = unit & 31, b = unit >> 5;
        const size_t T0 = (size_t)b * SEQ + ch * 64;
        LAS unsigned char* H = lds + h * GO_HEAD;
        LAS float* bt = (LAS float*)(H + GO_BT);
        const int il = 32 * it + c;
        u32x4 qraw[2];
#pragma unroll
        for (int s = 0; s < 2; ++s) qraw[s] = *(const u32x4*)(p.pb() + (T0 + il) * PBLD + GQ + h * 32 + 16 * s + 8 * hh);
#pragma unroll
        for (int i = 0; i < 4; ++i) { const int id = th + 128 * i, row = id >> 3, part = id & 7;
            const f32x4 bv = *(const f32x4*)(p.bcum() + (T0 + row) * 128 + h * 32 + part * 4);
            bt[row * G_BP + part * 4 + 0] = bv[0]; bt[row * G_BP + part * 4 + 1] = bv[1]; bt[row * G_BP + part * 4 + 2] = bv[2]; bt[row * G_BP + part * 4 + 3] = bv[3]; }
#pragma unroll
        for (int i = 0; i < 2; ++i) { const int id = th + 128 * i, v = id >> 2, part = id & 3;
            *(LAS u32x4*)(H + GO_ST + v * G_P32 + part * 16) = *(const u32x4*)(p.sgla() + ((size_t)((b * 4 + h) * 32 + ch)) * 2048 + v * 32 + part * 8); }
        __syncthreads();
#pragma unroll
        for (int i = 0; i < 4; ++i) { const int id = th + 128 * i, j = id >> 3, part = id & 7;
            const u32x4 vv = *(const u32x4*)(p.pb() + (T0 + j) * PBLD + GV + h * 64 + part * 8);
            scatter8(H + GO_VT, G_P64, part * 8, j, vv); }
#pragma unroll
        for (int i = 0; i < 2; ++i) { const int id = th + 128 * i, j = id >> 2, part = id & 3;
            const u32x4 kv = *(const u32x4*)(p.pb() + (T0 + j) * PBLD + GK + h * 32 + part * 8);
            float f[8];
#pragma unroll
            for (int e = 0; e < 8; ++e) f[e] = __expf(-bt[j * G_BP + part * 8 + e]);
            *(LAS u32x4*)(H + GO_KS + j * G_P32 + part * 16) = scale8v(kv, f); }
        bf16x8 qf[2];
#pragma unroll
        for (int s = 0; s < 2; ++s) {
            const u32x4 qv = qraw[s];
            float f[8];
#pragma unroll
            for (int e = 0; e < 8; ++e) f[e] = __expf(bt[il * G_BP + 16 * s + 8 * hh + e]);
            qf[s] = __builtin_bit_cast(bf16x8, scale8v(qv, f));
        }
        __syncthreads();
        f32x16 acc[2];
#pragma unroll
        for (int vt = 0; vt < 2; ++vt) {
#pragma unroll
            for (int i = 0; i < 16; ++i) acc[vt][i] = 0.f;
#pragma unroll
            for (int s = 0; s < 2; ++s) acc[vt] = MFMA32(lds_frag(H + GO_ST + (32 * vt + c) * G_P32 + (16 * s + 8 * hh) * 2), qf[s], acc[vt]);
        }
#pragma unroll 1
        for (int jt = 0; jt <= it; ++jt) {
            f32x16 st;
#pragma unroll
            for (int i = 0; i < 16; ++i) st[i] = 0.f;
#pragma unroll
            for (int s = 0; s < 2; ++s) st = MFMA32(lds_frag(H + GO_KS + (32 * jt + c) * G_P32 + (16 * s + 8 * hh) * 2), qf[s], st);
#pragma unroll
            for (int i = 0; i < 16; ++i) { const int jl = 32 * jt + (i & 3) + 8 * (i >> 2) + 4 * hh; st[i] = (jl <= il) ? st[i] : 0.f; }
            const bf16x8 p0 = pack8<0>(st), p1 = pack8<1>(st);
#pragma unroll
            for (int vt = 0; vt < 2; ++vt) {
                const LAS unsigned char* vp = H + GO_VT + (32 * vt + c) * G_P64 + (32 * jt + 4 * hh) * 2;
                acc[vt] = MFMA32(lds_frag_perm(vp), p0, acc[vt]);
                acc[vt] = MFMA32(lds_frag_perm(vp + 32), p1, acc[vt]);
            }
        }
        float ss = 0.f;
#pragma unroll
        for (int vt = 0; vt < 2; ++vt)
#pragma unroll
            for (int i = 0; i < 16; ++i) ss += acc[vt][i] * acc[vt][i];
        ss += __shfl_xor(ss, 32);
        const float rstd = rsqrtf(ss * (1.f / 64.f) + EPS);
        __syncthreads();
#pragma unroll
        for (int vt = 0; vt < 2; ++vt)
#pragma unroll
            for (int q4 = 0; q4 < 4; ++q4) {
                u32x2 w; w.x = pk2(acc[vt][4 * q4 + 0] * rstd, acc[vt][4 * q4 + 1] * rstd); w.y = pk2(acc[vt][4 * q4 + 2] * rstd, acc[vt][4 * q4 + 3] * rstd);
                *(LAS u32x2*)(H + GO_VT + il * G_P64 + (32 * vt + 8 * q4 + 4 * hh) * 2) = w;
            }
        u32x4 gate4[4];
#pragma unroll
        for (int i = 0; i < 4; ++i) { const int id = th + 128 * i, row = id >> 3, part = id & 7; gate4[i] = *(const u32x4*)(p.pb() + (T0 + row) * PBLD + GG + h * 64 + part * 8); }
        __syncthreads();
#pragma unroll
        for (int i = 0; i < 4; ++i) {
            const int id = th + 128 * i, row = id >> 3, part = id & 7;
            const u32x4 o8 = *(const LAS u32x4*)(H + GO_VT + row * G_P64 + part * 16);
            const u32x4 g8 = gate4[i];
            const float* gn = p.gla_g + l * 64 + part * 8;
            u32x4 r;
#pragma unroll
            for (int j = 0; j < 4; ++j) {
                const float o0 = __uint_as_float(o8[j] << 16), o1 = __uint_as_float(o8[j] & 0xffff0000u);
                const float g0 = __uint_as_float(g8[j] << 16), g1 = __uint_as_float(g8[j] & 0xffff0000u);
                r[j] = pk2(o0 * gn[2 * j] * fsilu(g0), o1 * gn[2 * j + 1] * fsilu(g1));
            }
            *(u32x4*)(p.mixb() + (T0 + row) * MLD + 768 + h * 64 + part * 8) = r;
        }
        __syncthreads();
    }
}

__device__ __forceinline__ void scan_phase(const Params& p) {
    int tid = threadIdx.x; asm volatile("" : "+v"(tid));
    for (int w = vcu_index(); w < 256; w += gridDim.x) {
        const int bh = w >> 3, part = w & 7;
        {
            const int e = part * 512 + tid;
            const float gam = 1.f - __builtin_amdgcn_exp2f(-5.f - (float)(bh & 3)), g128 = __builtin_amdgcn_exp2f(128.f * log2f(gam));
            const float* u = p.uret() + (size_t)(bh * 16) * 4096 + e;
            unsigned short* s = p.sret() + (size_t)(bh * 16) * 4096 + e;
            float U[15];
#pragma unroll
            for (int c = 0; c < 15; ++c) U[c] = u[(size_t)c * 4096];
            float S = 0.f; s[0] = 0;
#pragma unroll
            for (int c = 0; c < 15; ++c) { S = g128 * S + U[c]; s[(size_t)(c + 1) * 4096] = f2bf(S * gam); }
        }
        if (tid < 256) {
            const int e = part * 256 + tid, d = e & 31;
            const float* u = p.ugla() + (size_t)(bh * 32) * 2048 + e;
            const float* dd = p.dgla() + (size_t)(bh * 32) * 32 + d;
            unsigned short* s = p.sgla() + (size_t)(bh * 32) * 2048 + e;
            float U[31], D[31];
#pragma unroll
            for (int c = 0; c < 31; ++c) { U[c] = u[(size_t)c * 2048]; D[c] = dd[c * 32]; }
            float S = 0.f; s[0] = 0;
#pragma unroll
            for (int c = 0; c < 31; ++c) { S = D[c] * S + U[c]; s[(size_t)(c + 1) * 2048] = f2bf(S); }
        }
    }
}
}

#define XB_TMO      128
#define XB_XCNT(j)  (256  + 64 * (j))
#define XB_XSUB(j)  (1280 + 64 * (j))
#define XB_XGEN(j)  (2304 + 64 * (j))
#define XB_TOP      3328
#define XB_TOPGEN   3392
#define XCD_BAR_WORDS 3456
#define XB_SPIN_CAP (1u << 18)

__device__ __forceinline__ unsigned xb_ld(unsigned* p)              { return __hip_atomic_load(p, __ATOMIC_RELAXED, __HIP_MEMORY_SCOPE_AGENT); }
__device__ __forceinline__ unsigned xb_add(unsigned* p, unsigned v) { return __hip_atomic_fetch_add(p, v, __ATOMIC_RELAXED, __HIP_MEMORY_SCOPE_AGENT); }
__device__ __forceinline__ unsigned xb_xcc_id() { return (unsigned)__builtin_amdgcn_s_getreg((3 << 11) | 20) & 0xFu; }
#define XB_SPIN(cond, bar) do { unsigned _sp = 0; while (cond) { __builtin_amdgcn_s_sleep(1); \
    if ((++_sp & 255u) == 0u) { if (xb_ld(&(bar)[XB_TMO])) break; if (_sp > XB_SPIN_CAP) { atomicAdd(&(bar)[XB_TMO], 1u); break; } } } } while (0)

struct XcdBarrier {
    unsigned* bar; unsigned x;
    volatile LAS unsigned* st;
};

__device__ __forceinline__ XcdBarrier xcd_barrier_post(unsigned* bar, volatile LAS unsigned* st) {
    XcdBarrier b; b.bar = bar; b.x = xb_xcc_id(); b.st = st;
    if (threadIdx.x == 0) ((volatile LAS unsigned*)((LAS unsigned char*)g_lds + TM_OFF))[2] = xb_add(&bar[XB_XCNT(b.x)], 1u);
    return b;
}
__device__ __forceinline__ void xcd_barrier_complete(unsigned* bar, unsigned x, unsigned& nloc, unsigned& nx) {
    const unsigned G = gridDim.x * gridDim.y * gridDim.z;
    unsigned sum, cnt, mine, sp = 0u;
    for (;;) {
        sum = 0u; cnt = 0u; mine = 0u;
#pragma unroll
        for (unsigned j = 0; j < 16; ++j) { const unsigned c = xb_ld(&bar[XB_XCNT(j)]); sum += c; cnt += (c > 0u) ? 1u : 0u; mine = (j == x) ? c : mine; }
        if (sum == G) break;
        __builtin_amdgcn_s_sleep(1);
        if ((++sp & 255u) == 0u) { if (xb_ld(&bar[XB_TMO])) break; if (sp > XB_SPIN_CAP) { atomicAdd(&bar[XB_TMO], 1u); break; } }
    }
    nloc = mine > 0u ? mine : 1u; nx = cnt > 0u ? cnt : 1u;
}

__device__ __forceinline__ void xcd_barrier(const XcdBarrier& b) {
    asm volatile("s_waitcnt vmcnt(0)" ::: "memory");
    __syncthreads();
    if (threadIdx.x == 0) {
        unsigned* bar = b.bar;
        __builtin_amdgcn_s_waitcnt(0);
        unsigned nloc = b.st[0], nx = b.st[1];
        if (nloc == 0u) { xcd_barrier_complete(bar, b.x, nloc, nx); b.st[0] = nloc; b.st[1] = nx; }
        const unsigned old = xb_add(&bar[XB_XSUB(b.x)], 1u);
        const unsigned gen = old / nloc;
        if (old + 1u == (gen + 1u) * nloc) {
            __builtin_amdgcn_fence(__ATOMIC_RELEASE, "agent");
            asm volatile("s_waitcnt vmcnt(0)" ::: "memory");
            const unsigned og = xb_add(&bar[XB_TOP], 1u);
            const unsigned tg = og / nx;
            if (og + 1u == (tg + 1u) * nx) xb_add(&bar[XB_TOPGEN], 1u);
            else XB_SPIN(xb_ld(&bar[XB_TOPGEN]) == tg, bar);
            __builtin_amdgcn_fence(__ATOMIC_ACQUIRE, "agent");
            xb_add(&bar[XB_XGEN(b.x)], 1u);
            asm volatile("s_waitcnt vmcnt(0)" ::: "memory");
        } else {
            __builtin_amdgcn_fence(__ATOMIC_ACQUIRE, "agent");
            XB_SPIN(xb_ld(&bar[XB_XGEN(b.x)]) == gen, bar);
            asm volatile("s_waitcnt vmcnt(0)" ::: "memory");
        }
    }
    __syncthreads();
}


#define XB_TSUB(j)  (3456 + 64 * (j))
#define XB_TGEN(j)  (4480 + 64 * (j))
__device__ __forceinline__ void team_setup(const XcdBarrier& b) {
    volatile LAS unsigned* tm = (volatile LAS unsigned*)((LAS unsigned char*)g_lds + TM_OFF);
    if (threadIdx.x == 0) {
        unsigned ok = (gridDim.x == 256u) ? 1u : 0u, npop = 0u, before = 0u;
#pragma unroll
        for (unsigned j = 0; j < 16; ++j) { const unsigned c = xb_ld(&b.bar[XB_XCNT(j)]); if (c != 0u) { ++npop; if (c != 32u) ok = 0u; if (j < b.x) ++before; } }
        if (npop != 8u) ok = 0u;
        tm[0] = ok;
        if (ok) tm[1] = before * 32u + tm[2];
    }
    __syncthreads();
}
__device__ __forceinline__ void team_barrier(const XcdBarrier& b) {
    asm volatile("s_waitcnt vmcnt(0)" ::: "memory");
    __syncthreads();
    if (threadIdx.x == 0) {
        volatile LAS unsigned* tm = (volatile LAS unsigned*)((LAS unsigned char*)g_lds + TM_OFF);
        __builtin_amdgcn_s_waitcnt(0);
        const unsigned r = tm[3]; tm[3] = r + 1u;
        (void)xb_add(&b.bar[XB_TSUB(b.x)], 1u);
        __builtin_amdgcn_fence(__ATOMIC_ACQUIRE, "agent");
        XB_SPIN(xb_ld(&b.bar[XB_TSUB(b.x)]) < (r + 1u) * 32u, b.bar);
        asm volatile("s_waitcnt vmcnt(0)" ::: "memory");
    }
    __syncthreads();
}
__device__ __forceinline__ void seam_barrier(const XcdBarrier& b) {
    const unsigned tmode = __builtin_amdgcn_readfirstlane(((volatile LAS unsigned*)((LAS unsigned char*)g_lds + TM_OFF))[0]);
    if (tmode) team_barrier(b); else xcd_barrier(b);
}

#define LAUNDER() int tid_ = threadIdx.x, bid_ = blockIdx.x; asm volatile("" : "+v"(tid_)); asm volatile("" : "+s"(bid_))
__global__ void __launch_bounds__(NTHREADS, 2) fwd_mega(Params p) {
    extern __shared__ __attribute__((aligned(16))) unsigned char lds_raw[];
    float* smem = (float*)lds_raw;
    LAS unsigned char* lds = (LAS unsigned char*)lds_raw;
    volatile LAS unsigned* bst = (volatile LAS unsigned*)(lds + LDS_BYTES - 16);
    if (threadIdx.x < 4) { bst[threadIdx.x] = 0u; ((volatile LAS unsigned*)((LAS unsigned char*)g_lds + TM_OFF))[threadIdx.x] = (threadIdx.x == 1) ? (unsigned)vcu_from_block() : 0u; }
    __syncthreads();
    const XcdBarrier gbar = xcd_barrier_post(p.bar(), bst);
#define DUPN(k) (1 + ((PROBE_DUP >> (k)) & 1))
    {
        LAUNDER();
        const int blk0 = vcu_index();
        NormRows R; norm_issue<0, 4>(tid_, p.x, blk0 < MROWS / 64 ? blk0 : 0, R);
        asm volatile("" ::: "memory");
        phase_wprep(tid_, bid_, p, lds); phase_wprep_out(tid_, bid_, p); phase_wprep_fold(tid_, bid_, p);
        __syncthreads();
        phase_mod(tid_, bid_, p, smem);
        asm volatile("" ::: "memory");
        xcd_barrier(gbar);
        team_setup(gbar);
        if (blk0 < MROWS / 64) { norm_issue<4, 8>(tid_, p.x, blk0, R); norm_finish<0, 8>(tid_, p, 0, blk0, R); }
    }
    for (int blk = vcu_index() + gridDim.x; blk < MROWS / 64; blk += gridDim.x) {
        LAUNDER();
        NormRows R; norm_issue<0, 8>(tid_, p.x, blk, R);
        norm_finish<0, 8>(tid_, p, 0, blk, R);
    }
    xcd_barrier(gbar);
    for (int l = 0; l < DEPTH; ++l) {
        const float* xin = l == 0 ? p.x : p.out;
        const bool job_first = (vcu_index() & 1) != 0;
        if (job_first) mix::gla_logits_job(lds, p, l);
        for (int r_ = 0; r_ < DUPN(1); ++r_) {
            pg8::Gemm g{p.hb(), p.wt_in() + (size_t)l * NMAIN * DM, MROWS, NMAIN, DM, HLD};
            pg8::StaticOrder S; S.init(MROWS, NMAIN, gridDim.x, (gridDim.x == 256) ? (vcu_index() & 31) * 8 + (vcu_index() >> 5) : (int)blockIdx.x);
            LAS int* posl = (LAS int*)(lds + pg8::STAGE_BYTES);
            for (int i = threadIdx.x; i < 4 * 256; i += NTHREADS) { pg8::Unit uu; if (S.next(i >> 8, uu)) posl[i] = p.pos[uu.pm * 256 + (i & 255)]; }
            __syncthreads();
            pg8::EpiProj E{p.pb(), posl};
            pg8::gemm_phase<pg8::EpiProj, pg8::StaticOrder>(lds, g, S, E);
        }
        if (!job_first) mix::gla_logits_job(lds, p, l);
        seam_barrier(gbar);
        for (int r_ = 0; r_ < DUPN(7); ++r_) mix::ret_u_phase(lds, p);
        for (int r_ = 0; r_ < DUPN(8); ++r_) mix::gla_u_phase(lds, p, l);
        seam_barrier(gbar);
        for (int r_ = 0; r_ < DUPN(5); ++r_) mix::scan_phase(p);
        for (int r_ = 0; r_ < DUPN(2); ++r_) mix::attn_phase(lds, p, l);
        seam_barrier(gbar);
        for (int r_ = 0; r_ < DUPN(3); ++r_) mix::ret_out_phase(lds, p);
        for (int r_ = 0; r_ < DUPN(9); ++r_) mix::gla_out_phase(lds, p, l);
        seam_barrier(gbar);
        for (int r_ = 0; r_ < ((l == 0) ? DUPN(4) : 1); ++r_) op4::outproj_phase(lds, p, l, xin);
        if (l + 1 < DEPTH) seam_barrier(gbar);
    }
}

extern "C" void kernel_launch(void* const* d_in, const int* in_sizes, int n_in, void* d_out, int out_size, void* d_ws, size_t ws_size, hipStream_t stream) {
    static int grid_blocks = 0;
    if (!grid_blocks) {
        int dev = 0, cus = 0, per_cu = 0;
        (void)hipGetDevice(&dev);
        (void)hipDeviceGetAttribute(&cus, hipDeviceAttributeMultiprocessorCount, dev);
        if (hipFuncSetAttribute((const void*)fwd_mega, hipFuncAttributeMaxDynamicSharedMemorySize, LDS_BYTES) != hipSuccess) fprintf(stderr, "kernel_launch: hipFuncSetAttribute failed\n");
        (void)hipOccupancyMaxActiveBlocksPerMultiprocessor(&per_cu, fwd_mega, NTHREADS, LDS_BYTES);
        if (per_cu < 1) fprintf(stderr, "kernel_launch: occupancy query says %d\n", per_cu);
        grid_blocks = cus;
    }
    Params p{};
    p.x = (const float*)d_in[0]; p.c = (const float*)d_in[1]; p.pos = (const int*)d_in[2]; p.w_mod = (const float*)d_in[3]; p.b_mod = (const float*)d_in[4];
    p.pre_g = (const float*)d_in[5]; p.post_g = (const float*)d_in[6]; p.w_in = (const float*)d_in[7]; p.sinks = (const float*)d_in[8];
    p.gate_w = (const float*)d_in[9]; p.gate_b = (const float*)d_in[10]; p.gla_g = (const float*)d_in[11]; p.w_out = (const float*)d_in[12];
    p.out = (float*)d_out;
    p.ws = (unsigned char*)d_ws;
    if (WS_TOTAL > ws_size) { fprintf(stderr, "kernel_launch: workspace too small: need %zu have %zu\n", (size_t)WS_TOTAL, ws_size); return; }
    if (hipMemsetAsync((unsigned char*)d_ws + WS_BAR, 0, 32768, stream) != hipSuccess) { fprintf(stderr, "kernel_launch: memset of the barrier words failed\n"); return; }
    void* args[] = {&p};
    hipError_t e = hipLaunchCooperativeKernel((void*)fwd_mega, dim3(grid_blocks), dim3(NTHREADS), args, LDS_BYTES, stream);
    if (e != hipSuccess) fprintf(stderr, "cooperative launch failed: %s (grid %d)\n", hipGetErrorString(e), grid_blocks);
}
```

```cpp
#include <hip/hip_runtime.h>
#include <hip/hip_cooperative_groups.h>
#include <cstdio>
#include <cstdint>
namespace cg = cooperative_groups;

constexpr int NB = 8, SEQ = 2048, DM = 1024, DEPTH = 2, MROWS = NB * SEQ;
constexpr int DIN = 3088, NMAIN = 3072;
constexpr int PBLD = 3136, HLD = 1088, MLD = 1088;
constexpr int AQ = 0, AK = 512, AV = 640, AG = 768, RQ = 1280, RK = 1536, RV = 1792, RG = 2048, GQ = 2304, GK = 2432, GV = 2560, GG = 2816, GA = 3072;
constexpr float EPS = 1e-6f;
#ifndef PROBE_DUP
#define PROBE_DUP 0
#endif
constexpr int NTHREADS = 512, LDS_BYTES = 147456;
#define LAS __attribute__((address_space(3)))
extern __shared__ __attribute__((aligned(16))) unsigned char g_lds[];
constexpr int TM_OFF = LDS_BYTES - 32;
__device__ __forceinline__ int vcu_index() { int v = ((volatile LAS int*)((LAS unsigned char*)g_lds + TM_OFF))[1]; v = __builtin_amdgcn_readfirstlane(v); asm volatile("" : "+s"(v)); return v; }
__device__ __forceinline__ int vcu_from_block() { const int g = gridDim.x, bx = blockIdx.x; return (g % 8 == 0) ? (bx % 8) * (g / 8) + bx / 8 : bx; }

constexpr size_t WS_BAR = 0;
constexpr size_t WS_MOD = WS_BAR + 32768;
constexpr size_t WS_HB = WS_MOD + 196608;
constexpr size_t WS_WTIN = WS_HB + (size_t)MROWS * HLD * 2;
constexpr size_t WS_PB = WS_WTIN + (size_t)DEPTH * NMAIN * DM * 2;
constexpr size_t WS_MIXB = WS_PB + (size_t)MROWS * PBLD * 2;
constexpr size_t WS_X1B = WS_MIXB + (size_t)MROWS * MLD * 2;
constexpr size_t WS_WFOUT = WS_X1B + (size_t)MROWS * DM * 2;
constexpr size_t WS_URET = WS_WFOUT + (size_t)DEPTH * DM * DM * 2;
constexpr size_t WS_UGLA = WS_URET + (size_t)512 * 4096 * 4;
constexpr size_t WS_SRET = WS_UGLA + (size_t)1024 * 2048 * 4;
constexpr size_t WS_SGLA = WS_SRET + (size_t)512 * 4096 * 2;
constexpr size_t WS_BCUM = WS_SGLA + (size_t)1024 * 2048 * 2;
constexpr size_t WS_WFG = WS_BCUM + (size_t)MROWS * 128 * 4;
constexpr size_t WS_DGLA = WS_WFG + (size_t)DEPTH * 4 * 64 * 1024;
constexpr size_t WS_TOTAL = WS_DGLA + (size_t)1024 * 32 * 4;
struct Params {
    const float* x; const float* c; const int* pos; const float* w_mod; const float* b_mod;
    const float* pre_g; const float* post_g; const float* w_in; const float* sinks;
    const float* gate_w; const float* gate_b; const float* gla_g; const float* w_out;
    float* out; unsigned char* ws;
    __device__ __forceinline__ unsigned* bar() const { return (unsigned*)(ws + WS_BAR); }
    __device__ __forceinline__ float* mod() const { return (float*)(ws + WS_MOD); }
    __device__ __forceinline__ unsigned short* hb() const { return (unsigned short*)(ws + WS_HB); }
    __device__ __forceinline__ unsigned short* wt_in() const { return (unsigned short*)(ws + WS_WTIN); }
    __device__ __forceinline__ unsigned short* pb() const { return (unsigned short*)(ws + WS_PB); }
    __device__ __forceinline__ unsigned short* mixb() const { return (unsigned short*)(ws + WS_MIXB); }
    __device__ __forceinline__ unsigned short* x1b() const { return (unsigned short*)(ws + WS_X1B); }
    __device__ __forceinline__ unsigned short* wf_out() const { return (unsigned short*)(ws + WS_WFOUT); }
    __device__ __forceinline__ float* uret() const { return (float*)(ws + WS_URET); }
    __device__ __forceinline__ float* ugla() const { return (float*)(ws + WS_UGLA); }
    __device__ __forceinline__ unsigned short* sret() const { return (unsigned short*)(ws + WS_SRET); }
    __device__ __forceinline__ unsigned short* sgla() const { return (unsigned short*)(ws + WS_SGLA); }
    __device__ __forceinline__ float* bcum() const { return (float*)(ws + WS_BCUM); }
    __device__ __forceinline__ unsigned short* wfg() const { return (unsigned short*)(ws + WS_WFG); }
    __device__ __forceinline__ float* dgla() const { return (float*)(ws + WS_DGLA); }
};

typedef float f32x2_t __attribute__((ext_vector_type(2)));
typedef __bf16 bf16x2_t __attribute__((ext_vector_type(2)));
__device__ __forceinline__ unsigned pk2(float lo, float hi) { const f32x2_t v = {lo, hi}; return __builtin_bit_cast(unsigned, __builtin_convertvector(v, bf16x2_t)); }
__device__ __forceinline__ unsigned short f2bf(float f) { return (unsigned short)(pk2(f, 0.f) & 0xffffu); }
__device__ __forceinline__ float bf2f(unsigned short h) { return __uint_as_float(((unsigned)h) << 16); }
template <int CTRL, int ROWMASK> __device__ __forceinline__ float dpp_mov0(float v) { return __builtin_bit_cast(float, __builtin_amdgcn_update_dpp(0, __builtin_bit_cast(int, v), CTRL, ROWMASK, 0xf, true)); }
__device__ __forceinline__ float wave_sum(float v) {
    v += dpp_mov0<0xB1, 0xf>(v);
    v += dpp_mov0<0x4E, 0xf>(v);
    v += dpp_mov0<0x141, 0xf>(v);
    v += dpp_mov0<0x140, 0xf>(v);
    v += dpp_mov0<0x142, 0xa>(v);
    v += dpp_mov0<0x143, 0xc>(v);
    return __builtin_bit_cast(float, __builtin_amdgcn_readlane(__builtin_bit_cast(int, v), 63));
}
__device__ __forceinline__ float wave_max(float v) {
#pragma unroll
    for (int o = 1; o < 64; o <<= 1) v = fmaxf(v, __shfl_xor(v, o));
    return v;
}
__device__ __forceinline__ float silu(float v) { return v / (1.f + expf(-v)); }
__device__ __forceinline__ int phys_col(int c) { const bool rot = (c < 640) || (c >= 1280 && c < 1792); const int d = c & 63; return rot ? (c & ~63) + ((d < 32) ? 2 * d : 2 * (d - 32) + 1) : c; }
__device__ __forceinline__ int log_col(int pc) { const bool rot = (pc < 640) || (pc >= 1280 && pc < 1792); const int o = pc & 63; return rot ? (pc & ~63) + ((o & 1) ? 32 + (o >> 1) : (o >> 1)) : pc; }


namespace pg8 {
#define PG8_LAS __attribute__((address_space(3)))
typedef unsigned short bf16_t;
typedef short bf16x8 __attribute__((ext_vector_type(8)));
typedef float f32x4 __attribute__((ext_vector_type(4)));
typedef unsigned u32x4 __attribute__((ext_vector_type(4)));
constexpr int BM = 256, BK = 64, HALF = 128, HTB = HALF * BK * 2  , STAGE_BYTES = 8 * HTB, NXCD = 8, WGM = 8;

__host__ __device__ __forceinline__ int lds_byte(int r, int c) { const int st = (r >> 4) * 2 + (c >> 5), rr = r & 15, cc = c & 31, ob = rr * 64 + cc * 2; return st * 1024 + (ob ^ (((ob >> 9) & 1) << 5)); }
__host__ __device__ __forceinline__ void stage_rc(int b, int& R, int& C) { const int st = b / 1024, sb = b % 1024, swz = sb ^ (((sb >> 9) & 1) << 5); R = (st >> 1) * 16 + swz / 64; C = (st & 1) * 32 + (swz % 64) / 2; }
__host__ __device__ __forceinline__ int perm32(int rho) { const int n = rho >> 4, i = rho & 15; return 8 * (i >> 2) + 4 * n + (i & 3); }

struct Unit { int pm, pn; };
struct Gemm { const bf16_t* A; const bf16_t* Bt; int M, N, K, lda; };

struct StaticOrder {
    int nM, nN, nwg, G, c;
    __host__ __device__ void init(int M, int N, int G_, int c_) { nM = M / BM; nN = N / BM; nwg = nM * nN; G = G_; c = c_; }
    __host__ __device__ bool next(int i, Unit& u) const {
        const long L = (long)i * G + c; if (L >= nwg) return false;
        int wgid = (int)L; { const int q = nwg / NXCD, r = nwg % NXCD, xcd = wgid % NXCD, off = wgid / NXCD; wgid = (xcd < r ? xcd * (q + 1) : r * (q + 1) + (xcd - r) * q) + off; }
        const int nig = WGM * nN, gid = wgid / nig, fm = gid * WGM, gsz = (nM - fm) < WGM ? (nM - fm) : WGM;
        u.pm = fm + ((wgid % nig) % gsz); u.pn = (wgid % nig) / gsz; return true;
    }
    __device__ __forceinline__ void a_ready(const Unit&) const {}
    __device__ __forceinline__ void done(const Unit&) const {}
};
__device__ __forceinline__ unsigned cvt_pk_bf16(float lo, float hi) { unsigned r; asm volatile("v_cvt_pk_bf16_f32 %0, %1, %2" : "=v"(r) : "v"(lo), "v"(hi)); return r; }

struct EpiProj {
    static constexpr bool PERM = true, AFTER_DRAIN = false;
    bf16_t* O; const PG8_LAS int* posl;
    __device__ __forceinline__ static int rtype_of(int seg) { return (seg <= 4) ? 0 : ((seg >= 10 && seg <= 13) ? 1 : -1); }
    __device__ __forceinline__ static float scale_of(int seg) { return (seg <= 3 || seg == 12 || seg == 13) ? 0.125f : (seg == 18 ? 0.17677669529663687f : 1.0f); }
    __device__ __forceinline__ void operator()(const f32x4 (&acc)[2][2][4][2], const Unit& u, int slot, int, int, int) const {
        int t_ = threadIdx.x; asm volatile("" : "+v"(t_));
        const int wid = t_ >> 6, lane = t_ & 63, wr = wid >> 2, wc = wid & 3, fr = lane & 15, fq = lane >> 4;
        const int rl0 = wr * 64 + fr, row0 = u.pm * BM + rl0, col0 = u.pn * BM + wc * 32 + 8 * fq;
        const int ibase = 16 * (wc & 1) + 4 * fq;
        const int rt0 = rtype_of(u.pn * 2), rt1 = rtype_of(u.pn * 2 + 1), rt = rt0 >= 0 ? rt0 : rt1;
        const float sc0 = scale_of(u.pn * 2), sc1 = scale_of(u.pn * 2 + 1);
        float fv[4];
#pragma unroll
        for (int q = 0; q < 4; ++q) fv[q] = __builtin_amdgcn_exp2f(-(float)(ibase + q) * (rt == 1 ? 13.287712379549449f / 31.f : 13.287712379549449f / 32.f)) * 0.15915494309189535f;
#pragma unroll
        for (int it = 0; it < 8; ++it) {
            const int ai = it >> 2, m = it & 3;
            const int row = row0 + ai * HALF + m * 16;
            float cs[4], sn[4];
            if (rt >= 0) {
                const float pos = (float)posl[slot * 256 + rl0 + ai * HALF + m * 16];
#pragma unroll
                for (int q = 0; q < 4; ++q) { const float rev = pos * fv[q], fx = rev - __builtin_floorf(rev); cs[q] = __builtin_amdgcn_cosf(fx); sn[q] = __builtin_amdgcn_sinf(fx); }
            }
#pragma unroll
            for (int bj = 0; bj < 2; ++bj) {
                const bool rot = (bj == 0 ? rt0 : rt1) >= 0; const float sc = bj == 0 ? sc0 : sc1;
                f32x4 v0 = acc[ai][bj][m][0], v1 = acc[ai][bj][m][1];
                if (rot) {
                    f32x4 r0, r1;
                    r0[0] = v0[0] * cs[0] - v0[1] * sn[0]; r0[1] = v0[1] * cs[0] + v0[0] * sn[0];
                    r0[2] = v0[2] * cs[1] - v0[3] * sn[1]; r0[3] = v0[3] * cs[1] + v0[2] * sn[1];
                    r1[0] = v1[0] * cs[2] - v1[1] * sn[2]; r1[1] = v1[1] * cs[2] + v1[0] * sn[2];
                    r1[2] = v1[2] * cs[3] - v1[3] * sn[3]; r1[3] = v1[3] * cs[3] + v1[2] * sn[3];
                    v0 = r0; v1 = r1;
                }
                v0 = v0 * sc; v1 = v1 * sc;
                u32x4 w; w.x = cvt_pk_bf16(v0[0], v0[1]); w.y = cvt_pk_bf16(v0[2], v0[3]); w.z = cvt_pk_bf16(v1[0], v1[1]); w.w = cvt_pk_bf16(v1[2], v1[3]);
                *(u32x4*)(O + (size_t)row * PBLD + col0 + bj * HALF) = w;
            }
        }
    }
};
struct JobPrefetch {
    PG8_LAS unsigned char* lds; const unsigned short* rows; bool on;
    __device__ __forceinline__ bool ready(int) const { return on; }
    __device__ __forceinline__ void operator()() const {
        int t = threadIdx.x; asm volatile("" : "+v"(t));
        const int wid = __builtin_amdgcn_readfirstlane(t >> 6), lane = t & 63;
        const unsigned short* Ag = rows + lane * 8;
#pragma unroll
        for (int i = 0; i < 16; ++i) { const int r = wid * 8 + (i >> 1), half = i & 1;
            __builtin_amdgcn_global_load_lds((const unsigned*)(Ag + (size_t)r * HLD + half * 512), (PG8_LAS unsigned*)(lds + r * 2064 + half * 1024), 16, 0, 0); }
    }
};
struct NoPost { __device__ __forceinline__ bool ready(int) const { return false; } __device__ __forceinline__ void operator()() const {} };
template <class Epi, class Sched, class Post>
__device__ __forceinline__ void gemm_phase(PG8_LAS unsigned char* lds, const Gemm g, const Sched& S, const Epi& E, const Post& post) {
    int tid_l = threadIdx.x; asm volatile("" : "+v"(tid_l));
    const int tid = tid_l, wid = __builtin_amdgcn_readfirstlane(tid >> 6), lane = tid & 63, wr = wid >> 2, wc = wid & 3, fr = lane & 15, fq = lane >> 4;
    const int K = g.K, nt = K / BK;
    unsigned voffA[2], voffB[2];
#pragma unroll
    for (int i = 0; i < 2; ++i) { int R, C; stage_rc(tid * 16 + i * 8192, R, C); const int Rb = Epi::PERM ? ((R & ~31) + perm32(R & 31)) : R;
        voffA[i] = (unsigned)(R * g.lda + C) * 2u; voffB[i] = (unsigned)(Rb * K + C) * 2u; }
    const size_t kstep = (size_t)(BK * 2);
    const size_t hstepA = (size_t)HALF * g.lda * 2, hstepB = (size_t)HALF * K * 2;
    const size_t tstepA = 2 * hstepA, tstepB = 2 * hstepB;
    const unsigned ldsw = (unsigned)wid * 1024u;
    const int aoff = lds_byte(wr * 64 + fr, fq * 8), boff = lds_byte(wc * 32 + fr, fq * 8);
#define PG8_SA(b, h) (((b) * 2 + (h)) * HTB)
#define PG8_SB(b, h) ((4 + (b) * 2 + (h)) * HTB)
#define PG8_STAGE(bufoff, gbase, voff) do { _Pragma("unroll") for (int _i = 0; _i < 2; ++_i) \
        __builtin_amdgcn_global_load_lds((const unsigned*)((const char*)(gbase) + (voff)[_i]), (PG8_LAS unsigned*)(lds + (bufoff) + ldsw + _i * 8192), 16, 0, 0); } while (0)
#define PG8_LDA(dst, b, h) do { _Pragma("unroll") for (int m = 0; m < 4; ++m) _Pragma("unroll") for (int k = 0; k < 2; ++k) dst[m][k] = *(const PG8_LAS bf16x8*)(lds + PG8_SA(b, h) + aoff + m * 2048 + k * 1024); } while (0)
#define PG8_LDB(dst, b, h) do { _Pragma("unroll") for (int n = 0; n < 2; ++n) _Pragma("unroll") for (int k = 0; k < 2; ++k) dst[n][k] = *(const PG8_LAS bf16x8*)(lds + PG8_SB(b, h) + boff + n * 2048 + k * 1024); } while (0)
#define PG8_MMA(ai, bj, At, Bt) do { __builtin_amdgcn_s_setprio(1); _Pragma("unroll") for (int m = 0; m < 4; ++m) _Pragma("unroll") for (int n = 0; n < 2; ++n) _Pragma("unroll") for (int k = 0; k < 2; ++k) \
        acc[ai][bj][m][n] = __builtin_amdgcn_mfma_f32_16x16x32_bf16(Bt[n][k], At[m][k], acc[ai][bj][m][n], 0, 0, 0); __builtin_amdgcn_s_setprio(0); } while (0)
#define PG8_WAIT_V(n) asm volatile("s_waitcnt vmcnt(" #n ")" ::: "memory")
#define PG8_WAIT_L(n) asm volatile("s_waitcnt lgkmcnt(" #n ")" ::: "memory")
#define PG8_BAR __builtin_amdgcn_s_barrier()
#define PG8_SCHED __builtin_amdgcn_sched_barrier(0)
    Unit cur, nxt; int ui = 0; bool drained = false;
    if (!S.next(0, cur)) return;
    f32x4 acc[2][2][4][2];
#pragma unroll
    for (int a = 0; a < 2; ++a)
#pragma unroll
        for (int b = 0; b < 2; ++b)
#pragma unroll
            for (int m = 0; m < 4; ++m)
#pragma unroll
                for (int n = 0; n < 2; ++n) acc[a][b][m][n] = (f32x4){0.f, 0.f, 0.f, 0.f};
    bf16x8 At[4][2], B0[2][2], B1[2][2];
    const char* cA = (const char*)g.A + (size_t)cur.pm * tstepA; const char* cB = (const char*)g.Bt + (size_t)cur.pn * tstepB;
    S.a_ready(cur);
    PG8_STAGE(PG8_SB(0, 0), cB, voffB); PG8_STAGE(PG8_SA(0, 0), cA, voffA); PG8_STAGE(PG8_SB(0, 1), cB + hstepB, voffB); PG8_STAGE(PG8_SA(0, 1), cA + hstepA, voffA);
    if (wr == 1) PG8_BAR;
    PG8_WAIT_V(4); PG8_BAR;
    PG8_STAGE(PG8_SB(1, 0), cB + kstep, voffB); PG8_STAGE(PG8_SA(1, 0), cA + kstep, voffA); PG8_STAGE(PG8_SB(1, 1), cB + hstepB + kstep, voffB);
    PG8_WAIT_V(6); PG8_BAR;
    for (;;) {
        const bool has_next = S.next(ui + 1, nxt);
        const char* nA = has_next ? (const char*)g.A + (size_t)nxt.pm * tstepA : cA; const char* nB = has_next ? (const char*)g.Bt + (size_t)nxt.pn * tstepB : cB;
        for (int t = 0; t < nt; t += 2) {
            const bool last = (t == nt - 2);
            const char* a1 = cA + (size_t)(t + 1) * kstep;
            const char* a2 = last ? nA : cA + (size_t)(t + 2) * kstep; const char* b2 = last ? nB : cB + (size_t)(t + 2) * kstep;
            const char* a3 = a2 + kstep; const char* b3 = b2 + kstep;
            if (last && has_next) S.a_ready(nxt);
            PG8_LDB(B0, 0, 0); PG8_SCHED; PG8_LDA(At, 0, 0); PG8_STAGE(PG8_SA(1, 1), a1 + hstepA, voffA);
            PG8_WAIT_L(8); PG8_BAR; PG8_WAIT_L(0); PG8_MMA(0, 0, At, B0); PG8_BAR; PG8_SCHED;
            PG8_LDB(B1, 0, 1); PG8_STAGE(PG8_SB(0, 0), b2, voffB);
            PG8_BAR; PG8_WAIT_L(0); PG8_MMA(0, 1, At, B1); PG8_BAR;
            PG8_LDA(At, 0, 1); PG8_STAGE(PG8_SA(0, 0), a2, voffA);
            PG8_BAR; PG8_WAIT_L(0); PG8_MMA(1, 0, At, B0); PG8_BAR; PG8_SCHED;
            PG8_STAGE(PG8_SB(0, 1), b2 + hstepB, voffB);
            PG8_WAIT_V(6); PG8_BAR; PG8_MMA(1, 1, At, B1); PG8_BAR;
            PG8_LDB(B0, 1, 0); PG8_SCHED; PG8_LDA(At, 1, 0); PG8_STAGE(PG8_SA(0, 1), a2 + hstepA, voffA);
            PG8_WAIT_L(8); PG8_BAR; PG8_WAIT_L(0); PG8_MMA(0, 0, At, B0); PG8_BAR; PG8_SCHED;
            PG8_LDB(B1, 1, 1); PG8_STAGE(PG8_SB(1, 0), b3, voffB);
            PG8_BAR; PG8_WAIT_L(0); PG8_MMA(0, 1, At, B1); PG8_BAR;
            PG8_LDA(At, 1, 1); PG8_STAGE(PG8_SA(1, 0), a3, voffA);
            PG8_BAR; PG8_WAIT_L(0); PG8_MMA(1, 0, At, B0); PG8_BAR; PG8_SCHED;
            PG8_STAGE(PG8_SB(1, 1), b3 + hstepB, voffB);
            PG8_WAIT_V(6); PG8_BAR; PG8_MMA(1, 1, At, B1); PG8_BAR;
        }
        if constexpr (!Epi::AFTER_DRAIN) {
            if (!has_next && post.ready(ui)) {
                PG8_WAIT_V(0); if (wr == 0) PG8_BAR; PG8_BAR;
                drained = true;
                post();
            }
            E(acc, cur, ui, wc, fr, fq); S.done(cur);
        }
        if (!has_next) break;
#pragma unroll
        for (int a = 0; a < 2; ++a)
#pragma unroll
            for (int b = 0; b < 2; ++b)
#pragma unroll
                for (int m = 0; m < 4; ++m)
#pragma unroll
                    for (int n = 0; n < 2; ++n) acc[a][b][m][n] = (f32x4){0.f, 0.f, 0.f, 0.f};
        cur = nxt; cA = nA; cB = nB; ++ui;
    }
    if (!drained) {
        PG8_WAIT_V(0);
        if (wr == 0) PG8_BAR;
        PG8_BAR;
    }
    if constexpr (Epi::AFTER_DRAIN) { E.fused(acc, cur, wr, wc, fr, fq, lds, wid, lane); S.done(cur); }
#undef PG8_SA
#undef PG8_SB
#undef PG8_STAGE
#undef PG8_LDA
#undef PG8_LDB
#undef PG8_MMA
#undef PG8_WAIT_V
#undef PG8_WAIT_L
#undef PG8_BAR
#undef PG8_SCHED
}
}

__device__ __forceinline__ void phase_mod(const int tid_, const int bid_, const Params& p, float* smem) {
    float* sc = smem;
    float* red = smem + NB * DM;
    for (int i = tid_; i < NB * DM; i += NTHREADS) sc[i] = silu(p.c[i]);
    __syncthreads();
    const int wave = __builtin_amdgcn_readfirstlane(tid_ >> 6), lane = tid_ & 63, cl = lane & 31, kh = lane >> 5;
    const __amdgpu_buffer_rsrc_t wrs = __builtin_amdgcn_make_buffer_rsrc((void*)p.w_mod, 0, DEPTH * DM * 3 * DM * 4, 0x00020000);
    for (int grp = bid_; grp < DEPTH * 3 * DM / 32; grp += gridDim.x) {
        const int l = grp / (3 * DM / 32), j = (grp % (3 * DM / 32)) * 32 + cl, k0 = wave * 128 + kh * 64;
        const int voff = (kh * 64 * 3 * DM + j) * 4, soff = (l * DM + wave * 128) * 3 * DM * 4;
        float acc[NB];
#pragma unroll
        for (int b = 0; b < NB; ++b) acc[b] = 0.f;
#pragma unroll 1
        for (int hq = 0; hq < 2; ++hq) {
            float wv[32];
#pragma unroll
            for (int k = 0; k < 32; ++k) wv[k] = __builtin_bit_cast(float, __builtin_amdgcn_raw_buffer_load_b32(wrs, voff, soff + (hq * 32 + k) * 3 * DM * 4, 0));
#pragma unroll
            for (int kc = 0; kc < 8; ++kc) {
#pragma unroll
                for (int b = 0; b < NB; ++b) {
                    const float4 s0 = *(const float4*)&sc[b * DM + k0 + hq * 32 + 4 * kc];
                    acc[b] += s0.x * wv[4 * kc + 0] + s0.y * wv[4 * kc + 1] + s0.z * wv[4 * kc + 2] + s0.w * wv[4 * kc + 3];
                }
                asm volatile("" ::: "memory");
            }
        }
#pragma unroll
        for (int b = 0; b < NB; ++b) { acc[b] += __shfl_xor(acc[b], 32); if (kh == 0) red[(wave * NB + b) * 32 + cl] = acc[b]; }
        __syncthreads();
        if (tid_ < 256) {
            const int b = tid_ >> 5, c2 = tid_ & 31, j2 = (grp % (3 * DM / 32)) * 32 + c2;
            float t = p.b_mod[l * 3 * DM + j2];
#pragma unroll
            for (int w8 = 0; w8 < 8; ++w8) t += red[(w8 * NB + b) * 32 + c2];
            p.mod()[(size_t)(l * NB + b) * 3 * DM + j2] = t;
        }
        __syncthreads();
    }
    __syncthreads();
}

struct NormRows { float4 v[8][4]; };
template <int RA, int RB> __device__ __forceinline__ void norm_issue(const int tid_, const float* xin, int blk, NormRows& R) {
    const int lane = tid_ & 63, wv = tid_ >> 6;
#pragma unroll
    for (int r = RA; r < RB; ++r)
#pragma unroll
        for (int i = 0; i < 4; ++i) R.v[r][i] = *(const float4*)(xin + (size_t)(blk * 64 + wv * 8 + r) * DM + (lane + 64 * i) * 4);
}
struct NormCoef { float4 gg[4], sc[4], sh[4]; };
__device__ __forceinline__ void norm_coef(const int tid_, const Params& p, int l, int blk, NormCoef& C) {
    const int lane = tid_ & 63;
    const int b = (blk * 64) / SEQ;
    const float* shift = p.mod() + (size_t)(l * NB + b) * 3 * DM;
    const float* scale = shift + DM;
    const float* g = p.pre_g + l * DM;
#pragma unroll
    for (int i = 0; i < 4; ++i) { const int k = (lane + 64 * i) * 4; C.gg[i] = *(const float4*)(g + k); C.sc[i] = *(const float4*)(scale + k); C.sh[i] = *(const float4*)(shift + k); }
}
template <int RA, int RB> __device__ __forceinline__ void norm_finish(const int tid_, const Params& p, int l, int blk, const NormRows& R, const NormCoef& C, LAS unsigned char* ltile, const bool to_lds) {
    const int lane = tid_ & 63, wv = tid_ >> 6;
    float4 mg[4], ms[4];
#pragma unroll
    for (int i = 0; i < 4; ++i) { const float4 gg = C.gg[i], sc = C.sc[i]; ms[i] = C.sh[i];
        mg[i] = make_float4(gg.x * (1.f + sc.x), gg.y * (1.f + sc.y), gg.z * (1.f + sc.z), gg.w * (1.f + sc.w)); }
#pragma unroll
    for (int r = RA; r < RB; ++r) {
        const size_t row = (size_t)(blk * 64 + wv * 8 + r);
        float ss = 0.f;
#pragma unroll
        for (int i = 0; i < 4; ++i) ss += R.v[r][i].x * R.v[r][i].x + R.v[r][i].y * R.v[r][i].y + R.v[r][i].z * R.v[r][i].z + R.v[r][i].w * R.v[r][i].w;
        ss = wave_sum(ss);
        const float rstd = rsqrtf(ss * (1.f / DM) + EPS);
#pragma unroll
        for (int i = 0; i < 4; ++i) {
            const int k = (lane + 64 * i) * 4;
            uint2 o;
            o.x = pk2(R.v[r][i].x * rstd * mg[i].x + ms[i].x, R.v[r][i].y * rstd * mg[i].y + ms[i].y);
            o.y = pk2(R.v[r][i].z * rstd * mg[i].z + ms[i].z, R.v[r][i].w * rstd * mg[i].w + ms[i].w);
            *(uint2*)(p.hb() + row * HLD + k) = o;
            if (to_lds) { typedef unsigned nf_u32x2 __attribute__((ext_vector_type(2))); *(LAS nf_u32x2*)(ltile + (wv * 8 + r) * 2064 + k * 2) = (nf_u32x2){o.x, o.y}; }
        }
        __builtin_amdgcn_sched_barrier(0);
    }
}

__device__ __forceinline__ void p0_item_load(const float* W, int ldw, int N, int item, int lane, float (&tv)[32]) {
    const int nblk = N / 32, kb = item / nblk, nb = item % nblk;
    const float* src = W + (size_t)(64 * kb + (lane >> 5)) * ldw + log_col(32 * nb + (lane & 31));
#pragma unroll
    for (int i = 0; i < 32; ++i) tv[i] = src[(size_t)(2 * i) * ldw];
}
__device__ __forceinline__ void p0_item_store(int K, unsigned short* WT, int N, LAS float* scr, int item, int lane, const float (&tv)[32]) {
    const int nblk = N / 32, kb = item / nblk, nb = item % nblk, k0 = 64 * kb, n0 = 32 * nb;
#pragma unroll
    for (int i = 0; i < 32; ++i) scr[(2 * i + (lane >> 5)) * 33 + (lane & 31)] = tv[i];
    asm volatile("s_waitcnt lgkmcnt(0)" ::: "memory");
    const int c = lane & 7;
#pragma unroll
    for (int j = 0; j < 4; ++j) { const int n = (lane >> 3) + 8 * j; const LAS float* s = scr + (8 * c) * 33 + n;
        uint4 o; o.x = pk2(s[0 * 33], s[1 * 33]); o.y = pk2(s[2 * 33], s[3 * 33]); o.z = pk2(s[4 * 33], s[5 * 33]); o.w = pk2(s[6 * 33], s[7 * 33]);
        *(uint4*)(WT + (size_t)(n0 + n) * K + k0 + 8 * c) = o; }
    asm volatile("s_waitcnt lgkmcnt(0)" ::: "memory");
}
__device__ __forceinline__ void phase_wprep(const int tid_, const int bid_, const Params& p, LAS unsigned char* lds) {
    const int wave = tid_ >> 6, lane = tid_ & 63;
    LAS float* scr = (LAS float*)(lds + wave * 16384);
    const int gw = bid_ * (NTHREADS / 64) + wave, ngw = gridDim.x * (NTHREADS / 64);
    constexpr int ITEMS = (DM / 64) * (NMAIN / 32);
#pragma unroll 1
    for (int it = gw; it < DEPTH * ITEMS; it += 2 * ngw) {
        const int it2 = it + ngw;
        float ta[32], tb[32];
        p0_item_load(p.w_in + (size_t)(it / ITEMS) * DM * DIN, DIN, NMAIN, it % ITEMS, lane, ta);
        if (it2 < DEPTH * ITEMS) p0_item_load(p.w_in + (size_t)(it2 / ITEMS) * DM * DIN, DIN, NMAIN, it2 % ITEMS, lane, tb);
        p0_item_store(DM, p.wt_in() + (size_t)(it / ITEMS) * NMAIN * DM, NMAIN, scr, it % ITEMS, lane, ta);
        if (it2 < DEPTH * ITEMS) p0_item_store(DM, p.wt_in() + (size_t)(it2 / ITEMS) * NMAIN * DM, NMAIN, scr, it2 % ITEMS, lane, tb);
    }
}
__device__ __forceinline__ void phase_wprep_out(const int tid_, const int bid_, const Params& p) {
#pragma unroll 2
    for (int idx = bid_ * blockDim.x + tid_; idx < DEPTH * 32 * 64 * 64; idx += gridDim.x * blockDim.x) {
        const int l = idx / (32 * 64 * 64), r = idx % (32 * 64 * 64), ct = r / (64 * 64), s = (r / 64) % 64, lane = r % 64;
        const float* W = p.w_out + (size_t)l * DM * DM + (size_t)(16 * s + 8 * (lane >> 5)) * DM + 32 * ct + (lane & 31);
        uint4 o;
        o.x = pk2(W[0 * DM], W[1 * DM]); o.y = pk2(W[2 * DM], W[3 * DM]); o.z = pk2(W[4 * DM], W[5 * DM]); o.w = pk2(W[6 * DM], W[7 * DM]);
        *(uint4*)(p.wf_out() + (size_t)idx * 8) = o;
    }
}

__device__ __forceinline__ void phase_wprep_fold(const int tid_, const int bid_, const Params& p) {
    for (int idx = bid_ * blockDim.x + tid_; idx < DEPTH * 4 * 64 * 64; idx += gridDim.x * blockDim.x) {
        const int l = idx / (4 * 64 * 64), r = idx % (4 * 64 * 64), ct = r / (64 * 64), s = (r / 64) % 64, lane = r % 64;
        const int n = 32 * ct + (lane & 31), k0 = 16 * s + 8 * (lane >> 5);
        float gw[16];
#pragma unroll
        for (int q = 0; q < 16; ++q) gw[q] = p.gate_w[(l * 16 + q) * 128 + n];
        float v[8];
#pragma unroll
        for (int j = 0; j < 8; ++j) {
            const float4* wr = (const float4*)(p.w_in + (size_t)l * DM * DIN + (size_t)(k0 + j) * DIN + GA);
            float a = 0.f;
#pragma unroll
            for (int q = 0; q < 4; ++q) { const float4 t4 = wr[q]; a += t4.x * gw[4 * q] + t4.y * gw[4 * q + 1] + t4.z * gw[4 * q + 2] + t4.w * gw[4 * q + 3]; }
            v[j] = a;
        }
        uint4 o; o.x = pk2(v[0], v[1]); o.y = pk2(v[2], v[3]); o.z = pk2(v[4], v[5]); o.w = pk2(v[6], v[7]);
        *(uint4*)(p.wfg() + (size_t)idx * 8) = o;
    }
}

namespace op4 {
typedef short bf16x8 __attribute__((ext_vector_type(8)));
typedef float f32x16 __attribute__((ext_vector_type(16)));
constexpr int AROW = 2064;
typedef unsigned mixu32x2 __attribute__((ext_vector_type(2)));
static_assert(64 * AROW + 8192 <= LDS_BYTES - 16, "P4 LDS map");
static_assert(DEPTH == 2, "epi_rows<L0>: layer 0 reads the f32 input and feeds layer 1; layer 1 reads layer 0's bf16 copy and writes the output");
template <bool L0> __device__ __forceinline__ void epi_rows(LAS unsigned char* lds, const Params& p, int l, int row0, int wid, int tid0, int lane2, const float* xin,
                                                            const float4& sm_gg, const float4& sm_sh, const float4& sm_sc, const float4 (&sm_pg)[4], const float4 (&sm_gt)[4]) {
    float4 xa[L0 ? 8 : 1][4]; mixu32x2 xw[L0 ? 1 : 8][4];
    if constexpr (L0) {
#pragma unroll
        for (int rr = 0; rr < 8; ++rr)
#pragma unroll
            for (int j = 0; j < 4; ++j) xa[rr][j] = *(const float4*)(xin + (size_t)(row0 + wid * 8 + rr) * DM + (lane2 + 64 * j) * 4);
    } else {
#pragma unroll
        for (int rr = 0; rr < 8; ++rr)
#pragma unroll
            for (int j = 0; j < 4; ++j) xw[rr][j] = *(const mixu32x2*)(p.x1b() + (size_t)(row0 + wid * 8 + rr) * DM + (lane2 + 64 * j) * 4);
    }
    float4 v1[4];
    LAS pg8::f32x4* pv2 = (LAS pg8::f32x4*)(lds + 64 * AROW);
    LAS pg8::f32x4* pv3 = pv2 + 256;
    if (L0 && tid0 < 256) {
        const float4 gg = sm_gg, sh = sm_sh, sc = sm_sc;
        pv2[tid0] = (pg8::f32x4){gg.x * (1.f + sc.x), gg.y * (1.f + sc.y), gg.z * (1.f + sc.z), gg.w * (1.f + sc.w)};
        pv3[tid0] = (pg8::f32x4){sh.x, sh.y, sh.z, sh.w};
    }
#pragma unroll
    for (int j = 0; j < 4; ++j) { const float4 pg = sm_pg[j], gt = sm_gt[j]; v1[j] = make_float4(pg.x * gt.x, pg.y * gt.y, pg.z * gt.z, pg.w * gt.w); }
    __syncthreads();
#pragma unroll
    for (int rr = 0; rr < 8; ++rr) {
        const int lr = wid * 8 + rr; const size_t go = (size_t)(row0 + lr) * DM;
        const LAS mixu32x2* yr = (const LAS mixu32x2*)(lds + lr * AROW);
        float yv[4][4]; float ss = 0.f;
#pragma unroll
        for (int j = 0; j < 4; ++j) { const mixu32x2 w = yr[lane2 + 64 * j];
            yv[j][0] = __uint_as_float(w.x << 16); yv[j][1] = __uint_as_float(w.x & 0xffff0000u); yv[j][2] = __uint_as_float(w.y << 16); yv[j][3] = __uint_as_float(w.y & 0xffff0000u);
            ss += yv[j][0] * yv[j][0] + yv[j][1] * yv[j][1] + yv[j][2] * yv[j][2] + yv[j][3] * yv[j][3]; }
        ss = wave_sum(ss);
        const float rstd = rsqrtf(ss * (1.f / DM) + EPS);
        float ss2 = 0.f; float4 xn[4];
#pragma unroll
        for (int j = 0; j < 4; ++j) { const int k = (lane2 + 64 * j) * 4;
            float4 xr;
            if constexpr (L0) xr = xa[rr][j];
            else { const mixu32x2 w = xw[rr][j]; xr = make_float4(__uint_as_float(w.x << 16), __uint_as_float(w.x & 0xffff0000u), __uint_as_float(w.y << 16), __uint_as_float(w.y & 0xffff0000u)); }
            xn[j].x = xr.x + v1[j].x * (yv[j][0] * rstd); xn[j].y = xr.y + v1[j].y * (yv[j][1] * rstd);
            xn[j].z = xr.z + v1[j].z * (yv[j][2] * rstd); xn[j].w = xr.w + v1[j].w * (yv[j][3] * rstd);
            if constexpr (L0) { mixu32x2 w; w.x = pk2(xn[j].x, xn[j].y); w.y = pk2(xn[j].z, xn[j].w); *(mixu32x2*)(p.x1b() + go + k) = w; }
            else *(float4*)(p.out + go + k) = xn[j];
            ss2 += xn[j].x * xn[j].x + xn[j].y * xn[j].y + xn[j].z * xn[j].z + xn[j].w * xn[j].w; }
        if constexpr (L0) {
            ss2 = wave_sum(ss2);
            const float rstd2 = rsqrtf(ss2 * (1.f / DM) + EPS);
#pragma unroll
            for (int j = 0; j < 4; ++j) { const int k = (lane2 + 64 * j) * 4;
                const pg8::f32x4 g2 = pv2[lane2 + 64 * j], s3 = pv3[lane2 + 64 * j];
                uint2 o;
                o.x = pk2(xn[j].x * rstd2 * g2[0] + s3[0], xn[j].y * rstd2 * g2[1] + s3[1]);
                o.y = pk2(xn[j].z * rstd2 * g2[2] + s3[2], xn[j].w * rstd2 * g2[3] + s3[3]);
                *(uint2*)(p.hb() + (size_t)(row0 + lr) * HLD + k) = o;
                *(LAS mixu32x2*)(lds + lr * AROW + k * 2) = (mixu32x2){o.x, o.y}; }
        }
        __builtin_amdgcn_sched_barrier(0);
    }
}
__device__ __forceinline__ void outproj_phase(LAS unsigned char* lds, const Params& p, int l, const float* xin) {
    int tid0 = threadIdx.x; asm volatile("" : "+v"(tid0));
    const int wid = __builtin_amdgcn_readfirstlane(tid0 >> 6);
    const __amdgpu_buffer_rsrc_t brs = __builtin_amdgcn_make_buffer_rsrc((void*)(p.wf_out() + (size_t)l * DM * DM), 0, DM * DM * 2, 0x00020000);
    const bool have_q4 = gridDim.x == 256;
    for (int unit = vcu_index(); unit < MROWS / 64; unit += gridDim.x) {
        const int row0 = unit * 64, b = row0 / SEQ;
        int lane = tid0 & 63; asm volatile("" : "+v"(lane));
        const int c = lane & 31, hh = lane >> 5;
        {
            const unsigned short* Ag = p.mixb() + (size_t)row0 * MLD + lane * 8;
            if (!have_q4) {
#pragma unroll
                for (int i = 0; i < 16; ++i) { const int r = wid * 8 + (i >> 1), half = i & 1;
                    __builtin_amdgcn_global_load_lds((const unsigned*)(Ag + (size_t)r * MLD + half * 512), (LAS unsigned*)(lds + r * AROW + half * 1024), 16, 0, 0); }
            } else {
                const unsigned short* Aq = p.mixb() + (size_t)row0 * MLD + 512 + lane * 2;
#pragma unroll
                for (int i = 0; i < 8; ++i) { const int r = wid * 8 + i;
                    __builtin_amdgcn_global_load_lds((const unsigned*)(Ag + (size_t)r * MLD), (LAS unsigned*)(lds + r * AROW), 16, 0, 0);
                    __builtin_amdgcn_global_load_lds((const unsigned*)(Aq + (size_t)r * MLD), (LAS unsigned*)(lds + r * AROW + 1024), 4, 0, 0);
                    __builtin_amdgcn_global_load_lds((const unsigned*)(Aq + (size_t)r * MLD + 128), (LAS unsigned*)(lds + r * AROW + 1280), 4, 0, 0); }
            }
        }
        const int bvoff = lane * 16, bsoff = wid * 4 * 65536;
        const int rot = (((int)blockIdx.x >> 3) * 2 + ((int)blockIdx.x & 1)) & 63;
#define OP4_LDB(nt, s) __builtin_bit_cast(bf16x8, __builtin_amdgcn_raw_buffer_load_b128(brs, bvoff, bsoff + (nt) * 65536 + (s) * 1024, 0))
        f32x16 acc[2][4];
#pragma unroll
        for (int mt = 0; mt < 2; ++mt)
#pragma unroll
            for (int nt = 0; nt < 4; ++nt)
#pragma unroll
                for (int i = 0; i < 16; ++i) acc[mt][nt][i] = 0.f;
        bf16x8 Bq[4][4];
#pragma unroll
        for (int u = 0; u < 4; ++u)
#pragma unroll
            for (int nt = 0; nt < 4; ++nt) Bq[u][nt] = OP4_LDB(nt, (u + rot) & 63);
        asm volatile("s_waitcnt vmcnt(0)" ::: "memory");
        __syncthreads();
        const LAS unsigned char* a0p = lds + c * AROW + hh * 16;
        const LAS unsigned char* a1p = lds + (32 + c) * AROW + hh * 16;
        for (int s0 = 0; s0 < 64; s0 += 4) {
#pragma unroll
            for (int u = 0; u < 4; ++u) {
                const int s = (s0 + u + rot) & 63, sn = (((s0 + u + 4 < 64) ? s0 + u + 4 : 63) + rot) & 63;
                const bf16x8 a0 = *(const LAS bf16x8*)(a0p + s * 32);
                const bf16x8 a1 = *(const LAS bf16x8*)(a1p + s * 32);
#pragma unroll
                for (int nt = 0; nt < 4; ++nt) {
                    acc[0][nt] = __builtin_amdgcn_mfma_f32_32x32x16_bf16(a0, Bq[u][nt], acc[0][nt], 0, 0, 0);
                    acc[1][nt] = __builtin_amdgcn_mfma_f32_32x32x16_bf16(a1, Bq[u][nt], acc[1][nt], 0, 0, 0);
                }
                __builtin_amdgcn_sched_barrier(0);
#pragma unroll
                for (int nt = 0; nt < 4; ++nt) Bq[u][nt] = OP4_LDB(nt, sn);
                __builtin_amdgcn_sched_barrier(0);
            }
        }
        __syncthreads();
        int lane2 = tid0 & 63; asm volatile("" : "+v"(lane2));
        float4 sm_gg = make_float4(0.f, 0.f, 0.f, 0.f), sm_sh = sm_gg, sm_sc = sm_gg, sm_pg[4], sm_gt[4];
        if (l + 1 < DEPTH && tid0 < 256) {
            const float* md2 = p.mod() + (size_t)((l + 1) * NB + b) * 3 * DM;
            sm_gg = *(const float4*)(p.pre_g + (l + 1) * DM + tid0 * 4); sm_sh = *(const float4*)(md2 + tid0 * 4); sm_sc = *(const float4*)(md2 + DM + tid0 * 4);
        }
        {
            const float* gate = p.mod() + (size_t)(l * NB + b) * 3 * DM + 2 * DM;
            const float* pgp = p.post_g + l * DM;
#pragma unroll
            for (int j = 0; j < 4; ++j) { const int k = (lane2 + 64 * j) * 4; sm_pg[j] = *(const float4*)(pgp + k); sm_gt[j] = *(const float4*)(gate + k); }
        }
        {
            const int c2 = lane2 & 31, hh2 = lane2 >> 5;
            LAS unsigned short* yw = (LAS unsigned short*)(lds + (4 * hh2) * AROW) + 128 * wid + c2;
#pragma unroll
            for (int mt = 0; mt < 2; ++mt)
#pragma unroll
                for (int nt = 0; nt < 4; ++nt)
#pragma unroll
                    for (int i = 0; i < 16; ++i) yw[(32 * mt + (i & 3) + 8 * (i >> 2)) * (AROW / 2) + 32 * nt] = f2bf(acc[mt][nt][i]);
        }
        if (l == 0) epi_rows<true>(lds, p, l, row0, wid, tid0, lane2, xin, sm_gg, sm_sh, sm_sc, sm_pg, sm_gt);
        else        epi_rows<false>(lds, p, l, row0, wid, tid0, lane2, xin, sm_gg, sm_sh, sm_sc, sm_pg, sm_gt);
        __syncthreads();
    }
}
#undef OP4_LDB
}

namespace mix {
typedef short bf16x8 __attribute__((ext_vector_type(8)));
typedef short s16x4 __attribute__((ext_vector_type(4)));
typedef float f32x16 __attribute__((ext_vector_type(16)));
typedef unsigned u32x4 __attribute__((ext_vector_type(4)));
typedef unsigned u32x2 __attribute__((ext_vector_type(2)));
typedef float f32x4 __attribute__((ext_vector_type(4)));
#define MFMA32(a, b, c) __builtin_amdgcn_mfma_f32_32x32x16_bf16((a), (b), (c), 0, 0, 0)
__device__ __forceinline__ bf16x8 lds_frag(const LAS unsigned char* p) { return *(const LAS bf16x8*)p; }
__device__ __forceinline__ bf16x8 lds_frag_perm(const LAS unsigned char* p) { const s16x4 lo = *(const LAS s16x4*)p, hi = *(const LAS s16x4*)(p + 16); return __builtin_shufflevector(lo, hi, 0, 1, 2, 3, 4, 5, 6, 7); }
template <int S_> __device__ __forceinline__ bf16x8 pack8(const f32x16& x) {
    u32x4 w; w.x = pk2(x[8 * S_ + 0], x[8 * S_ + 1]); w.y = pk2(x[8 * S_ + 2], x[8 * S_ + 3]); w.z = pk2(x[8 * S_ + 4], x[8 * S_ + 5]); w.w = pk2(x[8 * S_ + 6], x[8 * S_ + 7]);
    return __builtin_bit_cast(bf16x8, w);
}
__device__ __forceinline__ float fsilu(float v) { return v * __builtin_amdgcn_rcpf(1.f + __expf(-v)); }

constexpr int A_KP = 144, A_VTP = 528, A_OP = 528;
constexpr int A_K = 0, A_VT = 256 * A_KP, A_O = A_VT + 64 * A_VTP, A_END = A_O + 128 * A_OP;
static_assert(A_END <= LDS_BYTES, "attention LDS map");
__device__ __forceinline__ void attn_phase(LAS unsigned char* lds, const Params& p, int l) {
    int tid = threadIdx.x; asm volatile("" : "+v"(tid));
    const int wid = __builtin_amdgcn_readfirstlane(tid >> 6), lane = tid & 63, c = lane & 31, hh = lane >> 5;
    for (int unit = vcu_index(); unit < NB * 2 * 16; unit += gridDim.x) {
        const int qb = unit & 15, kvh = (unit >> 4) & 1, b = unit >> 5;
        const size_t R0 = (size_t)b * SEQ + qb * 128;
        const int g = wid >> 1, rh = wid & 1, h = kvh * 4 + g;
        bf16x8 qfa[2][4];
#pragma unroll
        for (int rg = 0; rg < 2; ++rg) { const unsigned short* qsrc = p.pb() + (R0 + rh * 64 + rg * 32 + c) * PBLD + AQ + h * 64 + 8 * hh;
#pragma unroll
            for (int s = 0; s < 4; ++s) qfa[rg][s] = *(const bf16x8*)(qsrc + 16 * s); }
#pragma unroll
        for (int i = 0; i < 4; ++i) {
            const int id = tid + 512 * i, key = id >> 3, part = id & 7;
            long kr = (long)R0 - 128 + key; if (kr < (long)b * SEQ) kr = (long)b * SEQ;
            const unsigned short* srow = p.pb() + (size_t)kr * PBLD;
            const u32x4 kv = *(const u32x4*)(srow + AK + kvh * 64 + part * 8);
            const u32x4 vv = *(const u32x4*)(srow + AV + kvh * 64 + part * 8);
            *(LAS u32x4*)(lds + A_K + key * A_KP + part * 16) = kv;
            LAS unsigned short* vt = (LAS unsigned short*)(lds + A_VT + (part * 8) * A_VTP) + key;
            vt[0 * (A_VTP / 2)] = (unsigned short)(vv.x & 0xffffu); vt[1 * (A_VTP / 2)] = (unsigned short)(vv.x >> 16);
            vt[2 * (A_VTP / 2)] = (unsigned short)(vv.y & 0xffffu); vt[3 * (A_VTP / 2)] = (unsigned short)(vv.y >> 16);
            vt[4 * (A_VTP / 2)] = (unsigned short)(vv.z & 0xffffu); vt[5 * (A_VTP / 2)] = (unsigned short)(vv.z >> 16);
            vt[6 * (A_VTP / 2)] = (unsigned short)(vv.w & 0xffffu); vt[7 * (A_VTP / 2)] = (unsigned short)(vv.w >> 16);
        }
        __syncthreads();
        const float sink = p.sinks[l * 8 + h];
#pragma unroll
        for (int rg = 0; rg < 2; ++rg) {
            const int r0 = rh * 64 + rg * 32, m = r0 >> 5;
            bf16x8 qf[4];
#pragma unroll
            for (int s = 0; s < 4; ++s) qf[s] = qfa[rg][s];
            f32x16 st[5];
#pragma unroll
            for (int t = 0; t < 5; ++t) {
#pragma unroll
                for (int i = 0; i < 16; ++i) st[t][i] = 0.f;
#pragma unroll
                for (int s = 0; s < 4; ++s) st[t] = MFMA32(lds_frag(lds + A_K + ((m + t) * 32 + c) * A_KP + (16 * s + 8 * hh) * 2), qf[s], st[t]);
            }
            float mx = sink;
#pragma unroll
            for (int t = 0; t < 5; ++t) {
                const bool tile_ok = (qb > 0) || (m + t >= 4);
#pragma unroll
                for (int i = 0; i < 16; ++i) {
                    const int kl = (i & 3) + 8 * (i >> 2) + 4 * hh;
                    const bool valid = tile_ok && (t == 0 ? (kl > c) : (t == 4 ? (kl <= c) : true));
                    st[t][i] = valid ? st[t][i] : -1e30f;
                    mx = fmaxf(mx, st[t][i]);
                }
            }
            mx = fmaxf(mx, __shfl_xor(mx, 32));
            float sum = 0.f;
            const float mxl = mx * 1.4426950408889634f;
#pragma unroll
            for (int t = 0; t < 5; ++t)
#pragma unroll
                for (int i = 0; i < 16; ++i) { const float e = __builtin_amdgcn_exp2f(st[t][i] * 1.4426950408889634f - mxl); st[t][i] = e; sum += e; }
            sum += __shfl_xor(sum, 32);
            sum += __expf(sink - mx);
            const float inv = __builtin_amdgcn_rcpf(sum);
            f32x16 ot[2];
#pragma unroll
            for (int dt = 0; dt < 2; ++dt)
#pragma unroll
                for (int i = 0; i < 16; ++i) ot[dt][i] = 0.f;
#pragma unroll
            for (int t = 0; t < 5; ++t) {
                const bf16x8 p0 = pack8<0>(st[t]), p1 = pack8<1>(st[t]);
#pragma unroll
                for (int dt = 0; dt < 2; ++dt) {
                    const LAS unsigned char* vp = lds + A_VT + (32 * dt + c) * A_VTP + ((m + t) * 32 + 4 * hh) * 2;
                    ot[dt] = MFMA32(lds_frag_perm(vp), p0, ot[dt]);
                    ot[dt] = MFMA32(lds_frag_perm(vp + 32), p1, ot[dt]);
                }
            }
#pragma unroll
            for (int dt = 0; dt < 2; ++dt)
#pragma unroll
                for (int q4 = 0; q4 < 4; ++q4) {
                    u32x2 w; w.x = pk2(ot[dt][4 * q4 + 0] * inv, ot[dt][4 * q4 + 1] * inv); w.y = pk2(ot[dt][4 * q4 + 2] * inv, ot[dt][4 * q4 + 3] * inv);
                    *(LAS u32x2*)(lds + A_O + (r0 + c) * A_OP + (g * 64 + 32 * dt + 8 * q4 + 4 * hh) * 2) = w;
                }
        }
        u32x4 gate8[8];
#pragma unroll
        for (int i = 0; i < 8; ++i) { const int id = tid + 512 * i, row = id >> 5, part = id & 31;
            gate8[i] = *(const u32x4*)(p.pb() + (R0 + row) * PBLD + AG + kvh * 256 + part * 8); }
        __syncthreads();
#pragma unroll
        for (int i = 0; i < 8; ++i) {
            const int id = tid + 512 * i, row = id >> 5, part = id & 31;
            const u32x4 o8 = *(const LAS u32x4*)(lds + A_O + row * A_OP + part * 16);
            const u32x4 g8 = gate8[i];
            u32x4 r;
#pragma unroll
            for (int j = 0; j < 4; ++j) {
                const float o0 = __uint_as_float(o8[j] << 16), o1 = __uint_as_float(o8[j] & 0xffff0000u);
                const float g0 = __uint_as_float(g8[j] << 16), g1 = __uint_as_float(g8[j] & 0xffff0000u);
                r[j] = pk2(o0 * fsilu(g0), o1 * fsilu(g1));
            }
            *(u32x4*)(p.mixb() + (R0 + row) * MLD + kvh * 256 + part * 8) = r;
        }
        __syncthreads();
    }
}

constexpr int R_P128 = 272, R_P64 = 144;
constexpr int RU_VT = 0, RU_KT = 64 * R_P128, RU_GRP = 2 * 64 * R_P128;
static_assert(2 * RU_GRP <= LDS_BYTES, "ret U LDS map");
__device__ __forceinline__ void scatter8(LAS unsigned char* base, int pitch, int row0, int col, const u32x4 v) {
    LAS unsigned short* t = (LAS unsigned short*)(base + row0 * pitch) + col; const int ps = pitch / 2;
    t[0 * ps] = (unsigned short)(v.x & 0xffffu); t[1 * ps] = (unsigned short)(v.x >> 16); t[2 * ps] = (unsigned short)(v.y & 0xffffu); t[3 * ps] = (unsigned short)(v.y >> 16);
    t[4 * ps] = (unsigned short)(v.z & 0xffffu); t[5 * ps] = (unsigned short)(v.z >> 16); t[6 * ps] = (unsigned short)(v.w & 0xffffu); t[7 * ps] = (unsigned short)(v.w >> 16);
}
__device__ __forceinline__ u32x4 scale8(const u32x4 v, float f) {
    u32x4 r;
#pragma unroll
    for (int j = 0; j < 4; ++j) r[j] = pk2(__uint_as_float(v[j] << 16) * f, __uint_as_float(v[j] & 0xffff0000u) * f);
    return r;
}
__device__ __forceinline__ void ret_u_phase(LAS unsigned char* lds, const Params& p) {
    int tid = threadIdx.x; asm volatile("" : "+v"(tid));
    const int wid = __builtin_amdgcn_readfirstlane(tid >> 6), lane = tid & 63, c = lane & 31, hh = lane >> 5, grp = wid >> 2, wl = wid & 3, tg = tid & 255;
    for (int unit = vcu_index(); unit < 256; unit += gridDim.x) {
        const int hp = unit & 1, ch = (unit >> 1) & 15, b = unit >> 5, h = 2 * hp + grp;
        const size_t T0 = (size_t)b * SEQ + ch * 128;
        const float l2g = log2f(1.f - __builtin_amdgcn_exp2f(-5.f - (float)h));
        LAS unsigned char* G = lds + grp * RU_GRP;
#pragma unroll
        for (int i = 0; i < 4; ++i) {
            const int id = tg + 256 * i, j = id >> 3, part = id & 7;
            const unsigned short* srow = p.pb() + (T0 + j) * PBLD;
            const u32x4 kv = *(const u32x4*)(srow + RK + h * 64 + part * 8);
            const u32x4 vv = *(const u32x4*)(srow + RV + h * 64 + part * 8);
            scatter8(G + RU_KT, R_P128, part * 8, j, scale8(kv, __builtin_amdgcn_exp2f((float)(127 - j) * l2g)));
            scatter8(G + RU_VT, R_P128, part * 8, j, vv);
        }
        __syncthreads();
        const int vt = wl >> 1, dt = wl & 1;
        f32x16 acc;
#pragma unroll
        for (int i = 0; i < 16; ++i) acc[i] = 0.f;
#pragma unroll
        for (int s = 0; s < 8; ++s)
            acc = MFMA32(lds_frag(G + RU_VT + (32 * vt + c) * R_P128 + (16 * s + 8 * hh) * 2), lds_frag(G + RU_KT + (32 * dt + c) * R_P128 + (16 * s + 8 * hh) * 2), acc);
        float* ug = p.uret() + ((size_t)((b * 4 + h) * 16 + ch)) * 4096 + 32 * dt + c;
#pragma unroll
        for (int i = 0; i < 16; ++i) ug[(32 * vt + (i & 3) + 8 * (i >> 2) + 4 * hh) * 64] = acc[i];
        __syncthreads();
    }
}
constexpr int RO_K = 0, RO_VT = 128 * R_P64, RO_ST = RO_VT + 64 * R_P128, RO_OUT = RO_ST + 64 * R_P64, RO_GRP = RO_OUT + 128 * R_P64;
static_assert(2 * RO_GRP <= LDS_BYTES, "ret out LDS map");
__device__ __forceinline__ void ret_out_phase(LAS unsigned char* lds, const Params& p) {
    int tid = threadIdx.x; asm volatile("" : "+v"(tid));
    const int wid = __builtin_amdgcn_readfirstlane(tid >> 6), lane = tid & 63, c = lane & 31, hh = lane >> 5, grp = wid >> 2, it = wid & 3, tg = tid & 255;
    for (int unit = vcu_index(); unit < 256; unit += gridDim.x) {
        const int hp = unit & 1, ch = (unit >> 1) & 15, b = unit >> 5, h = 2 * hp + grp;
        const size_t T0 = (size_t)b * SEQ + ch * 128;
        const float gam = 1.f - __builtin_amdgcn_exp2f(-5.f - (float)h), l2g = log2f(gam);
        LAS unsigned char* G = lds + grp * RO_GRP;
        const int il = 32 * it + c;
        bf16x8 qf[4];
        { const unsigned short* qsrc = p.pb() + (T0 + il) * PBLD + RQ + h * 64 + 8 * hh;
#pragma unroll
          for (int s = 0; s < 4; ++s) qf[s] = *(const bf16x8*)(qsrc + 16 * s); }
#pragma unroll
        for (int i = 0; i < 4; ++i) {
            const int id = tg + 256 * i, j = id >> 3, part = id & 7;
            const unsigned short* srow = p.pb() + (T0 + j) * PBLD;
            const u32x4 kv = *(const u32x4*)(srow + RK + h * 64 + part * 8);
            const u32x4 vv = *(const u32x4*)(srow + RV + h * 64 + part * 8);
            *(LAS u32x4*)(G + RO_K + j * R_P64 + part * 16) = kv;
            scatter8(G + RO_VT, R_P128, part * 8, j, vv);
        }
#pragma unroll
        for (int i = 0; i < 2; ++i) { const int id = tg + 256 * i, v = id >> 3, part = id & 7;
            *(LAS u32x4*)(G + RO_ST + v * R_P64 + part * 16) = *(const u32x4*)(p.sret() + ((size_t)((b * 4 + h) * 16 + ch)) * 4096 + v * 64 + part * 8); }
        __syncthreads();
        f32x16 acc[2];
#pragma unroll
        for (int vt = 0; vt < 2; ++vt) {
#pragma unroll
            for (int i = 0; i < 16; ++i) acc[vt][i] = 0.f;
#pragma unroll
            for (int s = 0; s < 4; ++s) acc[vt] = MFMA32(lds_frag(G + RO_ST + (32 * vt + c) * R_P64 + (16 * s + 8 * hh) * 2), qf[s], acc[vt]);
        }
        const float gi = __builtin_amdgcn_exp2f((float)il * l2g);
#pragma unroll
        for (int vt = 0; vt < 2; ++vt)
#pragma unroll
            for (int i = 0; i < 16; ++i) acc[vt][i] *= gi;
#pragma unroll 1
        for (int jt = 0; jt <= it; ++jt) {
            f32x16 st;
#pragma unroll
            for (int i = 0; i < 16; ++i) st[i] = 0.f;
#pragma unroll
            for (int s = 0; s < 4; ++s) st = MFMA32(lds_frag(G + RO_K + (32 * jt + c) * R_P64 + (16 * s + 8 * hh) * 2), qf[s], st);
#pragma unroll
            for (int i = 0; i < 16; ++i) { const int jl = 32 * jt + (i & 3) + 8 * (i >> 2) + 4 * hh, dlt = il - jl;
                st[i] = dlt >= 0 ? st[i] * __builtin_amdgcn_exp2f((float)dlt * l2g) : 0.f; }
            const bf16x8 p0 = pack8<0>(st), p1 = pack8<1>(st);
#pragma unroll
            for (int vt = 0; vt < 2; ++vt) {
                const LAS unsigned char* vp = G + RO_VT + (32 * vt + c) * R_P128 + (32 * jt + 4 * hh) * 2;
                acc[vt] = MFMA32(lds_frag_perm(vp), p0, acc[vt]);
                acc[vt] = MFMA32(lds_frag_perm(vp + 32), p1, acc[vt]);
            }
        }
        float ss = 0.f;
#pragma unroll
        for (int vt = 0; vt < 2; ++vt)
#pragma unroll
            for (int i = 0; i < 16; ++i) ss += acc[vt][i] * acc[vt][i];
        ss += __shfl_xor(ss, 32);
        const float rstd = rsqrtf(ss * (1.f / 64.f) + EPS);
#pragma unroll
        for (int vt = 0; vt < 2; ++vt)
#pragma unroll
            for (int q4 = 0; q4 < 4; ++q4) {
                u32x2 w; w.x = pk2(acc[vt][4 * q4 + 0] * rstd, acc[vt][4 * q4 + 1] * rstd); w.y = pk2(acc[vt][4 * q4 + 2] * rstd, acc[vt][4 * q4 + 3] * rstd);
                *(LAS u32x2*)(G + RO_OUT + il * R_P64 + (32 * vt + 8 * q4 + 4 * hh) * 2) = w;
            }
        u32x4 gate4[4];
#pragma unroll
        for (int i = 0; i < 4; ++i) { const int id = tg + 256 * i, row = id >> 3, part = id & 7; gate4[i] = *(const u32x4*)(p.pb() + (T0 + row) * PBLD + RG + h * 64 + part * 8); }
        __syncthreads();
#pragma unroll
        for (int i = 0; i < 4; ++i) {
            const int id = tg + 256 * i, row = id >> 3, part = id & 7;
            const u32x4 o8 = *(const LAS u32x4*)(G + RO_OUT + row * R_P64 + part * 16);
            const u32x4 g8 = gate4[i];
            u32x4 r;
#pragma unroll
            for (int j = 0; j < 4; ++j) {
                const float o0 = __uint_as_float(o8[j] << 16), o1 = __uint_as_float(o8[j] & 0xffff0000u);
                const float g0 = __uint_as_float(g8[j] << 16), g1 = __uint_as_float(g8[j] & 0xffff0000u);
                r[j] = pk2(o0 * fsilu(g0), o1 * fsilu(g1));
            }
            *(u32x4*)(p.mixb() + (T0 + row) * MLD + 512 + h * 64 + part * 8) = r;
        }
        __syncthreads();
    }
}

constexpr int G_P32 = 80, G_P64 = 144, G_BP = 33;
constexpr int GU_BT = 0, GU_VT = 64 * G_BP * 4, GU_KT = GU_VT + 64 * G_P64, GU_HEAD = GU_KT + 32 * G_P64, GU_AROW = 2064;
constexpr int GU_XCH = 4 * GU_HEAD;
static_assert(64 * GU_AROW <= LDS_BYTES && GU_XCH + 32768 <= LDS_BYTES - 16, "gla logits LDS map");
static_assert(4 * GU_HEAD <= LDS_BYTES, "gla U LDS map");
__device__ __forceinline__ u32x4 scale8v(const u32x4 v, const float* f) {
    u32x4 r;
#pragma unroll
    for (int j = 0; j < 4; ++j) r[j] = pk2(__uint_as_float(v[j] << 16) * f[2 * j], __uint_as_float(v[j] & 0xffff0000u) * f[2 * j + 1]);
    return r;
}
__device__ __forceinline__ void gla_logits_job(LAS unsigned char* lds, const Params& p, int l, const bool have_tile) {
    int tid = threadIdx.x; asm volatile("" : "+v"(tid));
    const int wid = __builtin_amdgcn_readfirstlane(tid >> 6), lane = tid & 63, c = lane & 31, hh = lane >> 5, h = wid >> 1, vt = wid & 1, th = tid & 127;
    const __amdgpu_buffer_rsrc_t wrs = __builtin_amdgcn_make_buffer_rsrc((void*)(p.wfg() + (size_t)l * 4 * 64 * 512), 0, 4 * 64 * 1024, 0x00020000);
    for (int unit = vcu_index(); unit < 256; unit += gridDim.x) {
        const int ch = unit & 31, b = unit >> 5;
        const size_t T0 = (size_t)b * SEQ + ch * 64;
        LAS unsigned char* H = lds + h * GU_HEAD;
        LAS float* bt = (LAS float*)(H + GU_BT);
        {
            const int kh = wid >> 2, nt = wid & 3;
            if (!have_tile) {
                const unsigned short* Ag = p.hb() + T0 * HLD + lane * 8;
#pragma unroll
                for (int i = 0; i < 16; ++i) { const int r = wid * 8 + (i >> 1), half = i & 1;
                    __builtin_amdgcn_global_load_lds((const unsigned*)(Ag + (size_t)r * HLD + half * 512), (LAS unsigned*)(lds + r * GU_AROW + half * 1024), 16, 0, 0); }
            }
            const int bso = nt * 65536 + kh * 32768;
            bf16x8 rb[16];
#pragma unroll
            for (int u = 0; u < 16; ++u) rb[u] = __builtin_bit_cast(bf16x8, __builtin_amdgcn_raw_buffer_load_b128(wrs, lane * 16, bso + u * 1024, 0));
            asm volatile("s_waitcnt vmcnt(0)" ::: "memory");
            __syncthreads();
            const LAS unsigned char* apl = lds + c * GU_AROW + hh * 16 + kh * 1024;
            f32x16 lg0, lg1;
#pragma unroll
            for (int i = 0; i < 16; ++i) { lg0[i] = 0.f; lg1[i] = 0.f; }
            bf16x8 fa0 = *(const LAS bf16x8*)(apl), fa1 = *(const LAS bf16x8*)(apl + 32 * GU_AROW);
            for (int s0 = 0; s0 < 32; s0 += 16) {
#pragma unroll
                for (int u = 0; u < 16; ++u) {
                    const int s = s0 + u, sn = (s + 16 < 32) ? s + 16 : 31, sa = (s + 1 < 32) ? s + 1 : 31;
                    const bf16x8 na0 = *(const LAS bf16x8*)(apl + sa * 32), na1 = *(const LAS bf16x8*)(apl + 32 * GU_AROW + sa * 32);
                    __builtin_amdgcn_sched_barrier(0);
                    lg0 = MFMA32(fa0, rb[u], lg0);
                    lg1 = MFMA32(fa1, rb[u], lg1);
                    __builtin_amdgcn_sched_barrier(0);
                    rb[u] = __builtin_bit_cast(bf16x8, __builtin_amdgcn_raw_buffer_load_b128(wrs, lane * 16, bso + sn * 1024, 0));
                    fa0 = na0; fa1 = na1;
                    __builtin_amdgcn_sched_barrier(0);
                }
            }
            __syncthreads();
            LAS float* xr = (LAS float*)(lds + GU_XCH) + (nt * 32) * 64 + lane;
            if (kh == 1) {
#pragma unroll
                for (int i = 0; i < 16; ++i) xr[i * 64] = lg0[i];
            } else {
#pragma unroll
                for (int i = 0; i < 16; ++i) xr[(16 + i) * 64] = lg1[i];
            }
            __syncthreads();
            {
                const float gb = p.gate_b[l * 128 + 32 * nt + c];
                LAS float* btn = (LAS float*)(lds + nt * GU_HEAD + GU_BT);
#pragma unroll
                for (int i = 0; i < 16; ++i) {
                    const float x = (kh == 0 ? lg0[i] + xr[i * 64] : lg1[i] + xr[(16 + i) * 64]) + gb;
                    const int r = (i & 3) + 8 * (i >> 2) + 4 * hh + (kh == 0 ? 0 : 32);
                    btn[r * G_BP + c] = (fminf(x, 0.f) - __logf(1.f + __expf(-fabsf(x)))) * (1.f / 16.f);
                }
            }
        }
        __syncthreads();
        {
            const int d = th & 31, seg = th >> 5;
            LAS float* tot = (LAS float*)(H + GU_VT);
            float v[16]; float a = 0.f;
#pragma unroll
            for (int i = 0; i < 16; ++i) v[i] = bt[(16 * seg + i) * G_BP + d];
#pragma unroll
            for (int i = 0; i < 16; ++i) { a += v[i]; v[i] = a; }
            tot[seg * 32 + d] = a;
            __syncthreads();
            float off = 0.f;
#pragma unroll
            for (int q = 0; q < 3; ++q) off += (q < seg) ? tot[q * 32 + d] : 0.f;
            float* bg = p.bcum() + (T0 + 16 * seg) * 128 + h * 32 + d;
#pragma unroll
            for (int i = 0; i < 16; ++i) bg[(size_t)i * 128] = v[i] + off;
        }
        __syncthreads();
    }
}
__device__ __forceinline__ void gla_u_phase(LAS unsigned char* lds, const Params& p, int l) {
    int tid = threadIdx.x; asm volatile("" : "+v"(tid));
    const int wid = __builtin_amdgcn_readfirstlane(tid >> 6), lane = tid & 63, c = lane & 31, hh = lane >> 5, h = wid >> 1, vt = wid & 1, th = tid & 127;
    for (int unit = vcu_index(); unit < 256; unit += gridDim.x) {
        const int ch = unit & 31, b = unit >> 5;
        const size_t T0 = (size_t)b * SEQ + ch * 64;
        LAS unsigned char* H = lds + h * GU_HEAD;
        LAS float* bt = (LAS float*)(H + GU_BT);
#pragma unroll
        for (int i = 0; i < 4; ++i) { const int id = th + 128 * i, row = id >> 3, part = id & 7;
            const f32x4 bv = *(const f32x4*)(p.bcum() + (T0 + row) * 128 + h * 32 + part * 4);
            bt[row * G_BP + part * 4 + 0] = bv[0]; bt[row * G_BP + part * 4 + 1] = bv[1]; bt[row * G_BP + part * 4 + 2] = bv[2]; bt[row * G_BP + part * 4 + 3] = bv[3]; }
        __syncthreads();
#pragma unroll
        for (int i = 0; i < 4; ++i) { const int id = th + 128 * i, j = id >> 3, part = id & 7;
            const u32x4 vv = *(const u32x4*)(p.pb() + (T0 + j) * PBLD + GV + h * 64 + part * 8);
            scatter8(H + GU_VT, G_P64, part * 8, j, vv); }
#pragma unroll
        for (int i = 0; i < 2; ++i) { const int id = th + 128 * i, j = id >> 2, part = id & 3;
            const u32x4 kv = *(const u32x4*)(p.pb() + (T0 + j) * PBLD + GK + h * 32 + part * 8);
            float f[8];
#pragma unroll
            for (int e = 0; e < 8; ++e) f[e] = __expf(-bt[j * G_BP + part * 8 + e]);
            scatter8(H + GU_KT, G_P64, part * 8, j, scale8v(kv, f)); }
        __syncthreads();
        f32x16 acc;
#pragma unroll
        for (int i = 0; i < 16; ++i) acc[i] = 0.f;
#pragma unroll
        for (int s = 0; s < 4; ++s)
            acc = MFMA32(lds_frag(H + GU_VT + (32 * vt + c) * G_P64 + (16 * s + 8 * hh) * 2), lds_frag(H + GU_KT + c * G_P64 + (16 * s + 8 * hh) * 2), acc);
        const float dl = __expf(bt[63 * G_BP + c]);
        const size_t ui = (size_t)((b * 4 + h) * 32 + ch);
        float* ug = p.ugla() + ui * 2048 + c;
#pragma unroll
        for (int i = 0; i < 16; ++i) ug[(32 * vt + (i & 3) + 8 * (i >> 2) + 4 * hh) * 32] = acc[i] * dl;
        if (vt == 0 && hh == 0) p.dgla()[ui * 32 + c] = dl;
        __syncthreads();
    }
}
constexpr int GO_BT = 0, GO_KS = 64 * G_BP * 4, GO_VT = GO_KS + 64 * G_P32, GO_ST = GO_VT + 64 * G_P64, GO_HEAD = GO_ST + 64 * G_P32;
static_assert(4 * GO_HEAD <= LDS_BYTES, "gla out LDS map");
__device__ __forceinline__ void gla_out_phase(LAS unsigned char* lds, const Params& p, int l, const bool keep_tile) {
    int tid = threadIdx.x; asm volatile("" : "+v"(tid));
    const int wid = __builtin_amdgcn_readfirstlane(tid >> 6), lane = tid & 63, c = lane & 31, hh = lane >> 5, h = wid >> 1, it = wid & 1, th = tid & 127;
    for (int unit = vcu_index(); unit < 256; unit += gridDim.x) {
        const int ch = unit & 31, b = unit >> 5;
        const size_t T0 = (size_t)b * SEQ + ch * 64;
        LAS unsigned char* H = lds + h * GO_HEAD;
        LAS float* bt = (LAS float*)(H + GO_BT);
        const int il = 32 * it + c;
        u32x4 qraw[2];
#pragma unroll
        for (int s = 0; s < 2; ++s) qraw[s] = *(const u32x4*)(p.pb() + (T0 + il) * PBLD + GQ + h * 32 + 16 * s + 8 * hh);
#pragma unroll
        for (int i = 0; i < 4; ++i) { const int id = th + 128 * i, row = id >> 3, part = id & 7;
            const f32x4 bv = *(const f32x4*)(p.bcum() + (T0 + row) * 128 + h * 32 + part * 4);
            bt[row * G_BP + part * 4 + 0] = bv[0]; bt[row * G_BP + part * 4 + 1] = bv[1]; bt[row * G_BP + part * 4 + 2] = bv[2]; bt[row * G_BP + part * 4 + 3] = bv[3]; }
#pragma unroll
        for (int i = 0; i < 2; ++i) { const int id = th + 128 * i, v = id >> 2, part = id & 3;
            *(LAS u32x4*)(H + GO_ST + v * G_P32 + part * 16) = *(const u32x4*)(p.sgla() + ((size_t)((b * 4 + h) * 32 + ch)) * 2048 + v * 32 + part * 8); }
        __syncthreads();
#pragma unroll
        for (int i = 0; i < 4; ++i) { const int id = th + 128 * i, j = id >> 3, part = id & 7;
            const u32x4 vv = *(const u32x4*)(p.pb() + (T0 + j) * PBLD + GV + h * 64 + part * 8);
            scatter8(H + GO_VT, G_P64, part * 8, j, vv); }
#pragma unroll
        for (int i = 0; i < 2; ++i) { const int id = th + 128 * i, j = id >> 2, part = id & 3;
            const u32x4 kv = *(const u32x4*)(p.pb() + (T0 + j) * PBLD + GK + h * 32 + part * 8);
            float f[8];
#pragma unroll
            for (int e = 0; e < 8; ++e) f[e] = __expf(-bt[j * G_BP + part * 8 + e]);
            *(LAS u32x4*)(H + GO_KS + j * G_P32 + part * 16) = scale8v(kv, f); }
        bf16x8 qf[2];
#pragma unroll
        for (int s = 0; s < 2; ++s) {
            const u32x4 qv = qraw[s];
            float f[8];
#pragma unroll
            for (int e = 0; e < 8; ++e) f[e] = __expf(bt[il * G_BP + 16 * s + 8 * hh + e]);
            qf[s] = __builtin_bit_cast(bf16x8, scale8v(qv, f));
        }
        __syncthreads();
        f32x16 acc[2];
#pragma unroll
        for (int vt = 0; vt < 2; ++vt) {
#pragma unroll
            for (int i = 0; i < 16; ++i) acc[vt][i] = 0.f;
#pragma unroll
            for (int s = 0; s < 2; ++s) acc[vt] = MFMA32(lds_frag(H + GO_ST + (32 * vt + c) * G_P32 + (16 * s + 8 * hh) * 2), qf[s], acc[vt]);
        }
#pragma unroll 1
        for (int jt = 0; jt <= it; ++jt) {
            f32x16 st;
#pragma unroll
            for (int i = 0; i < 16; ++i) st[i] = 0.f;
#pragma unroll
            for (int s = 0; s < 2; ++s) st = MFMA32(lds_frag(H + GO_KS + (32 * jt + c) * G_P32 + (16 * s + 8 * hh) * 2), qf[s], st);
#pragma unroll
            for (int i = 0; i < 16; ++i) { const int jl = 32 * jt + (i & 3) + 8 * (i >> 2) + 4 * hh; st[i] = (jl <= il) ? st[i] : 0.f; }
            const bf16x8 p0 = pack8<0>(st), p1 = pack8<1>(st);
#pragma unroll
            for (int vt = 0; vt < 2; ++vt) {
                const LAS unsigned char* vp = H + GO_VT + (32 * vt + c) * G_P64 + (32 * jt + 4 * hh) * 2;
                acc[vt] = MFMA32(lds_frag_perm(vp), p0, acc[vt]);
                acc[vt] = MFMA32(lds_frag_perm(vp + 32), p1, acc[vt]);
            }
        }
        float ss = 0.f;
#pragma unroll
        for (int vt = 0; vt < 2; ++vt)
#pragma unroll
            for (int i = 0; i < 16; ++i) ss += acc[vt][i] * acc[vt][i];
        ss += __shfl_xor(ss, 32);
        const float rstd = rsqrtf(ss * (1.f / 64.f) + EPS);
        __syncthreads();
#pragma unroll
        for (int vt = 0; vt < 2; ++vt)
#pragma unroll
            for (int q4 = 0; q4 < 4; ++q4) {
                u32x2 w; w.x = pk2(acc[vt][4 * q4 + 0] * rstd, acc[vt][4 * q4 + 1] * rstd); w.y = pk2(acc[vt][4 * q4 + 2] * rstd, acc[vt][4 * q4 + 3] * rstd);
                *(LAS u32x2*)(H + GO_VT + il * G_P64 + (32 * vt + 8 * q4 + 4 * hh) * 2) = w;
            }
        u32x4 gate4[4];
#pragma unroll
        for (int i = 0; i < 4; ++i) { const int id = th + 128 * i, row = id >> 3, part = id & 7; gate4[i] = *(const u32x4*)(p.pb() + (T0 + row) * PBLD + GG + h * 64 + part * 8); }
        __syncthreads();
        u32x4 rk[4];
#pragma unroll
        for (int i = 0; i < 4; ++i) {
            const int id = th + 128 * i, row = id >> 3, part = id & 7;
            const u32x4 o8 = *(const LAS u32x4*)(H + GO_VT + row * G_P64 + part * 16);
            const u32x4 g8 = gate4[i];
            const float* gn = p.gla_g + l * 64 + part * 8;
            u32x4 r;
#pragma unroll
            for (int j = 0; j < 4; ++j) {
                const float o0 = __uint_as_float(o8[j] << 16), o1 = __uint_as_float(o8[j] & 0xffff0000u);
                const float g0 = __uint_as_float(g8[j] << 16), g1 = __uint_as_float(g8[j] & 0xffff0000u);
                r[j] = pk2(o0 * gn[2 * j] * fsilu(g0), o1 * gn[2 * j + 1] * fsilu(g1));
            }
            *(u32x4*)(p.mixb() + (T0 + row) * MLD + 768 + h * 64 + part * 8) = r;
            rk[i] = r;
        }
        __syncthreads();
        if (keep_tile) {
#pragma unroll
            for (int i = 0; i < 4; ++i) { const int id = th + 128 * i, row = id >> 3, part = id & 7;
                *(LAS u32x4*)(lds + row * 2064 + (768 + h * 64 + part * 8) * 2) = rk[i]; }
        }
    }
}

__device__ __forceinline__ void scan_phase(const Params& p) {
    int tid = threadIdx.x; asm volatile("" : "+v"(tid));
    for (int w = vcu_index(); w < 256; w += gridDim.x) {
        const int bh = w >> 3, part = w & 7;
        {
            const int e = part * 512 + tid;
            const float gam = 1.f - __builtin_amdgcn_exp2f(-5.f - (float)(bh & 3)), g128 = __builtin_amdgcn_exp2f(128.f * log2f(gam));
            const float* u = p.uret() + (size_t)(bh * 16) * 4096 + e;
            unsigned short* s = p.sret() + (size_t)(bh * 16) * 4096 + e;
            float U[15];
#pragma unroll
            for (int c = 0; c < 15; ++c) U[c] = u[(size_t)c * 4096];
            float S = 0.f; s[0] = 0;
#pragma unroll
            for (int c = 0; c < 15; ++c) { S = g128 * S + U[c]; s[(size_t)(c + 1) * 4096] = f2bf(S * gam); }
        }
        if (tid < 256) {
            const int e = part * 256 + tid, d = e & 31;
            const float* u = p.ugla() + (size_t)(bh * 32) * 2048 + e;
            const float* dd = p.dgla() + (size_t)(bh * 32) * 32 + d;
            unsigned short* s = p.sgla() + (size_t)(bh * 32) * 2048 + e;
            float U[31], D[31];
#pragma unroll
            for (int c = 0; c < 31; ++c) { U[c] = u[(size_t)c * 2048]; D[c] = dd[c * 32]; }
            float S = 0.f; s[0] = 0;
#pragma unroll
            for (int c = 0; c < 31; ++c) { S = D[c] * S + U[c]; s[(size_t)(c + 1) * 2048] = f2bf(S); }
        }
    }
}
}

#define XB_TMO      128
#define XB_XCNT(j)  (256  + 64 * (j))
#define XB_XSUB(j)  (1280 + 64 * (j))
#define XB_XGEN(j)  (2304 + 64 * (j))
#define XB_TOP      3328
#define XB_TOPGEN   3392
#define XCD_BAR_WORDS 3456
#define XB_SPIN_CAP (1u << 18)

__device__ __forceinline__ unsigned xb_ld(unsigned* p)              { return __hip_atomic_load(p, __ATOMIC_RELAXED, __HIP_MEMORY_SCOPE_AGENT); }
__device__ __forceinline__ unsigned xb_add(unsigned* p, unsigned v) { return __hip_atomic_fetch_add(p, v, __ATOMIC_RELAXED, __HIP_MEMORY_SCOPE_AGENT); }
__device__ __forceinline__ unsigned xb_xcc_id() { return (unsigned)__builtin_amdgcn_s_getreg((3 << 11) | 20) & 0xFu; }
#define XB_SPIN(cond, bar) do { unsigned _sp = 0; while (cond) { __builtin_amdgcn_s_sleep(1); \
    if ((++_sp & 255u) == 0u) { if (xb_ld(&(bar)[XB_TMO])) break; if (_sp > XB_SPIN_CAP) { atomicAdd(&(bar)[XB_TMO], 1u); break; } } } } while (0)

struct XcdBarrier {
    unsigned* bar; unsigned x;
    volatile LAS unsigned* st;
};

__device__ __forceinline__ XcdBarrier xcd_barrier_post(unsigned* bar, volatile LAS unsigned* st) {
    XcdBarrier b; b.bar = bar; b.x = xb_xcc_id(); b.st = st;
    if (threadIdx.x == 0) ((volatile LAS unsigned*)((LAS unsigned char*)g_lds + TM_OFF))[2] = xb_add(&bar[XB_XCNT(b.x)], 1u);
    return b;
}
__device__ __forceinline__ void xcd_barrier_complete(unsigned* bar, unsigned x, unsigned& nloc, unsigned& nx) {
    const unsigned G = gridDim.x * gridDim.y * gridDim.z;
    unsigned sum, cnt, mine, sp = 0u;
    for (;;) {
        sum = 0u; cnt = 0u; mine = 0u;
#pragma unroll
        for (unsigned j = 0; j < 16; ++j) { const unsigned c = xb_ld(&bar[XB_XCNT(j)]); sum += c; cnt += (c > 0u) ? 1u : 0u; mine = (j == x) ? c : mine; }
        if (sum == G) break;
        __builtin_amdgcn_s_sleep(1);
        if ((++sp & 255u) == 0u) { if (xb_ld(&bar[XB_TMO])) break; if (sp > XB_SPIN_CAP) { atomicAdd(&bar[XB_TMO], 1u); break; } }
    }
    nloc = mine > 0u ? mine : 1u; nx = cnt > 0u ? cnt : 1u;
}

__device__ __forceinline__ void xcd_barrier(const XcdBarrier& b) {
    asm volatile("s_waitcnt vmcnt(0)" ::: "memory");
    __syncthreads();
    if (threadIdx.x == 0) {
        unsigned* bar = b.bar;
        __builtin_amdgcn_s_waitcnt(0);
        unsigned nloc = b.st[0], nx = b.st[1];
        if (nloc == 0u) { xcd_barrier_complete(bar, b.x, nloc, nx); b.st[0] = nloc; b.st[1] = nx; }
        const unsigned old = xb_add(&bar[XB_XSUB(b.x)], 1u);
        const unsigned gen = old / nloc;
        if (old + 1u == (gen + 1u) * nloc) {
            __builtin_amdgcn_fence(__ATOMIC_RELEASE, "agent");
            asm volatile("s_waitcnt vmcnt(0)" ::: "memory");
            const unsigned og = xb_add(&bar[XB_TOP], 1u);
            const unsigned tg = og / nx;
            if (og + 1u == (tg + 1u) * nx) xb_add(&bar[XB_TOPGEN], 1u);
            else XB_SPIN(xb_ld(&bar[XB_TOPGEN]) == tg, bar);
            __builtin_amdgcn_fence(__ATOMIC_ACQUIRE, "agent");
            xb_add(&bar[XB_XGEN(b.x)], 1u);
            asm volatile("s_waitcnt vmcnt(0)" ::: "memory");
        } else {
            __builtin_amdgcn_fence(__ATOMIC_ACQUIRE, "agent");
            XB_SPIN(xb_ld(&bar[XB_XGEN(b.x)]) == gen, bar);
            asm volatile("s_waitcnt vmcnt(0)" ::: "memory");
        }
    }
    __syncthreads();
}


#define XB_TSUB(j)  (3456 + 64 * (j))
#define XB_TGEN(j)  (4480 + 64 * (j))
__device__ __forceinline__ void team_setup(const XcdBarrier& b) {
    volatile LAS unsigned* tm = (volatile LAS unsigned*)((LAS unsigned char*)g_lds + TM_OFF);
    if (threadIdx.x == 0) {
        unsigned ok = (gridDim.x == 256u) ? 1u : 0u, npop = 0u, before = 0u;
#pragma unroll
        for (unsigned j = 0; j < 16; ++j) { const unsigned c = xb_ld(&b.bar[XB_XCNT(j)]); if (c != 0u) { ++npop; if (c != 32u) ok = 0u; if (j < b.x) ++before; } }
        if (npop != 8u) ok = 0u;
        tm[0] = ok;
        if (ok) tm[1] = before * 32u + tm[2];
    }
    __syncthreads();
}
__device__ __forceinline__ void team_barrier(const XcdBarrier& b) {
    asm volatile("s_waitcnt vmcnt(0)" ::: "memory");
    __syncthreads();
    if (threadIdx.x == 0) {
        volatile LAS unsigned* tm = (volatile LAS unsigned*)((LAS unsigned char*)g_lds + TM_OFF);
        __builtin_amdgcn_s_waitcnt(0);
        const unsigned r = tm[3]; tm[3] = r + 1u;
        const unsigned old = xb_add(&b.bar[XB_TSUB(b.x)], 1u);
        if (old + 1u == (r + 1u) * 32u) (void)xb_add(&b.bar[XB_TGEN(b.x)], 1u);
        __builtin_amdgcn_fence(__ATOMIC_ACQUIRE, "agent");
        XB_SPIN(xb_ld(&b.bar[XB_TGEN(b.x)]) < r + 1u, b.bar);
        asm volatile("s_waitcnt vmcnt(0)" ::: "memory");
    }
    __syncthreads();
}
__device__ __forceinline__ void seam_barrier(const XcdBarrier& b) {
    const unsigned tmode = __builtin_amdgcn_readfirstlane(((volatile LAS unsigned*)((LAS unsigned char*)g_lds + TM_OFF))[0]);
    if (tmode) team_barrier(b); else xcd_barrier(b);
}

constexpr int TOUCH_OFF = LDS_BYTES - 32 - 1024;
template <int KIB> __device__ __forceinline__ void touch_region(const void* base, LAS unsigned char* lds) {
    int t = threadIdx.x; asm volatile("" : "+v"(t));
    const int u = vcu_index();
    if (u < 256) {
        const unsigned char* q = (const unsigned char*)base + (size_t)u * (KIB * 8192) + (t >> 6) * (KIB * 1024) + (t & 63) * 16;
#pragma unroll
        for (int i = 0; i < KIB; ++i) __builtin_amdgcn_global_load_lds((const unsigned*)(q + i * 1024), (LAS unsigned*)(lds + TOUCH_OFF), 16, 0, 0);
    }
}

__device__ __forceinline__ void touch_mix_rows(const unsigned short* mixb, LAS unsigned char* lds) {
    int t = threadIdx.x; asm volatile("" : "+v"(t));
    const int u = vcu_index();
    if (u < 256) {
        const unsigned short* q = mixb + (size_t)(u * 64 + (t >> 6) * 8) * MLD + (t & 63) * 8;
#pragma unroll
        for (int i = 0; i < 8; ++i) __builtin_amdgcn_global_load_lds((const unsigned*)(q + (size_t)i * MLD), (LAS unsigned*)(lds + TOUCH_OFF), 16, 0, 0);
    }
}
constexpr int POSL_OFF = 140288;
static_assert(POSL_OFF >= pg8::STAGE_BYTES && POSL_OFF + 4096 <= TOUCH_OFF && POSL_OFF >= 64 * op4::AROW + 8192, "positions LDS slot");
__device__ __forceinline__ int gemm_vblock() { return (gridDim.x == 256) ? (vcu_index() & 31) * 8 + (vcu_index() >> 5) : (int)blockIdx.x; }
__device__ __forceinline__ void stage_positions(LAS unsigned char* lds, const Params& p) {
    int t = threadIdx.x; asm volatile("" : "+v"(t));
    pg8::StaticOrder S; S.init(MROWS, NMAIN, gridDim.x, gemm_vblock());
    LAS int* posl = (LAS int*)(lds + POSL_OFF);
    for (int i = t; i < 4 * 256; i += NTHREADS) { pg8::Unit uu; if (S.next(i >> 8, uu)) posl[i] = p.pos[uu.pm * 256 + (i & 255)]; }
}

#define LAUNDER() int tid_ = threadIdx.x, bid_ = blockIdx.x; asm volatile("" : "+v"(tid_)); asm volatile("" : "+s"(bid_))
__global__ void __launch_bounds__(NTHREADS, 2) fwd_mega(Params p) {
    extern __shared__ __attribute__((aligned(16))) unsigned char lds_raw[];
    float* smem = (float*)lds_raw;
    LAS unsigned char* lds = (LAS unsigned char*)lds_raw;
    volatile LAS unsigned* bst = (volatile LAS unsigned*)(lds + LDS_BYTES - 16);
    if (threadIdx.x < 4) { bst[threadIdx.x] = 0u; ((volatile LAS unsigned*)((LAS unsigned char*)g_lds + TM_OFF))[threadIdx.x] = (threadIdx.x == 1) ? (unsigned)vcu_from_block() : 0u; }
    __syncthreads();
    const XcdBarrier gbar = xcd_barrier_post(p.bar(), bst);
#define DUPN(k) (1 + ((PROBE_DUP >> (k)) & 1))
    {
        LAUNDER();
        phase_wprep(tid_, bid_, p, lds);
        __syncthreads();
        if (tid_ == 0) { unsigned nloc, nx; xcd_barrier_complete(gbar.bar, gbar.x, nloc, nx); bst[0] = nloc; bst[1] = nx; }
        team_setup(gbar);
        const int blk0 = vcu_index();
        NormRows R; norm_issue<0, 4>(tid_, p.x, blk0 < MROWS / 64 ? blk0 : 0, R);
        asm volatile("" ::: "memory");
        phase_wprep_out(tid_, bid_, p); phase_wprep_fold(tid_, bid_, p);
        __syncthreads();
        phase_mod(tid_, bid_, p, smem);
        asm volatile("" ::: "memory");
        xcd_barrier(gbar);
        if (blk0 < MROWS / 64) { NormCoef C; norm_coef(tid_, p, 0, blk0, C); norm_issue<4, 8>(tid_, p.x, blk0, R); norm_finish<0, 8>(tid_, p, 0, blk0, R, C, lds, true); }
    }
    for (int blk = vcu_index() + gridDim.x; blk < MROWS / 64; blk += gridDim.x) {
        LAUNDER();
        NormRows R; NormCoef C; norm_coef(tid_, p, 0, blk, C); norm_issue<0, 8>(tid_, p.x, blk, R);
        norm_finish<0, 8>(tid_, p, 0, blk, R, C, lds, false);
    }
    touch_region<3>(p.wt_in(), lds);
    stage_positions(lds, p);
    seam_barrier(gbar);
    for (int l = 0; l < DEPTH; ++l) {
        const float* xin = l == 0 ? p.x : p.out;
        const bool job_first = (vcu_index() & 1) != 0;
        if (job_first) mix::gla_logits_job(lds, p, l, gridDim.x == 256);
        for (int r_ = 0; r_ < DUPN(1); ++r_) {
            pg8::Gemm g{p.hb(), p.wt_in() + (size_t)l * NMAIN * DM, MROWS, NMAIN, DM, HLD};
            pg8::StaticOrder S; S.init(MROWS, NMAIN, gridDim.x, gemm_vblock());
            LAS int* posl = (LAS int*)(lds + POSL_OFF);
            pg8::EpiProj E{p.pb(), posl};
            const pg8::JobPrefetch jp{lds, p.hb() + (size_t)vcu_index() * 64 * HLD, !job_first && gridDim.x == 256};
            pg8::gemm_phase<pg8::EpiProj, pg8::StaticOrder>(lds, g, S, E, jp);
        }
        if (!job_first) mix::gla_logits_job(lds, p, l, gridDim.x == 256);
        seam_barrier(gbar);
        for (int r_ = 0; r_ < DUPN(7); ++r_) mix::ret_u_phase(lds, p);
        for (int r_ = 0; r_ < DUPN(8); ++r_) mix::gla_u_phase(lds, p, l);
        seam_barrier(gbar);
        for (int r_ = 0; r_ < DUPN(5); ++r_) mix::scan_phase(p);
        for (int r_ = 0; r_ < DUPN(2); ++r_) mix::attn_phase(lds, p, l);
        seam_barrier(gbar);
        for (int r_ = 0; r_ < DUPN(3); ++r_) mix::ret_out_phase(lds, p);
        for (int r_ = 0; r_ < DUPN(9); ++r_) mix::gla_out_phase(lds, p, l, gridDim.x == 256);
        touch_region<1>(p.wf_out() + (size_t)l * DM * DM, lds);
        touch_mix_rows(p.mixb(), lds);
        seam_barrier(gbar);
        for (int r_ = 0; r_ < ((l == 0) ? DUPN(4) : 1); ++r_) op4::outproj_phase(lds, p, l, xin);
        if (l + 1 < DEPTH) { touch_region<3>(p.wt_in() + (size_t)(l + 1) * NMAIN * DM, lds); stage_positions(lds, p); seam_barrier(gbar); }
    }
}

extern "C" void kernel_launch(void* const* d_in, const int* in_sizes, int n_in, void* d_out, int out_size, void* d_ws, size_t ws_size, hipStream_t stream) {
    static int grid_blocks = 0;
    if (!grid_blocks) {
        int dev = 0, cus = 0, per_cu = 0;
        (void)hipGetDevice(&dev);
        (void)hipDeviceGetAttribute(&cus, hipDeviceAttributeMultiprocessorCount, dev);
        if (hipFuncSetAttribute((const void*)fwd_mega, hipFuncAttributeMaxDynamicSharedMemorySize, LDS_BYTES) != hipSuccess) fprintf(stderr, "kernel_launch: hipFuncSetAttribute failed\n");
        (void)hipOccupancyMaxActiveBlocksPerMultiprocessor(&per_cu, fwd_mega, NTHREADS, LDS_BYTES);
        if (per_cu < 1) fprintf(stderr, "kernel_launch: occupancy query says %d\n", per_cu);
        grid_blocks = cus;
    }
    Params p{};
    p.x = (const float*)d_in[0]; p.c = (const float*)d_in[1]; p.pos = (const int*)d_in[2]; p.w_mod = (const float*)d_in[3]; p.b_mod = (const float*)d_in[4];
    p.pre_g = (const float*)d_in[5]; p.post_g = (const float*)d_in[6]; p.w_in = (const float*)d_in[7]; p.sinks = (const float*)d_in[8];
    p.gate_w = (const float*)d_in[9]; p.gate_b = (const float*)d_in[10]; p.gla_g = (const float*)d_in[11]; p.w_out = (const float*)d_in[12];
    p.out = (float*)d_out;
    p.ws = (unsigned char*)d_ws;
    if (WS_TOTAL > ws_size) { fprintf(stderr, "kernel_launch: workspace too small: need %zu have %zu\n", (size_t)WS_TOTAL, ws_size); return; }
    if (hipMemsetAsync((unsigned char*)d_ws + WS_BAR, 0, 32768, stream) != hipSuccess) { fprintf(stderr, "kernel_launch: memset of the barrier words failed\n"); return; }
    void* args[] = {&p};
    hipError_t e = hipLaunchCooperativeKernel((void*)fwd_mega, dim3(grid_blocks), dim3(NTHREADS), args, LDS_BYTES, stream);
    if (e != hipSuccess) fprintf(stderr, "cooperative launch failed: %s (grid %d)\n", hipGetErrorString(e), grid_blocks);
}
```
